# Optimizing an MI355X kernel written in HIP

```python
import math, functools
import jax, jax.numpy as jnp
from jax import lax
import numpy as np

D_MODEL = 1024
BATCH = 2
SEQ = 16384
DEPTH = 4

GRID_W = 64
CTX_LEN = 256
N_MIXERS = 3
N_A_LAYERS = (DEPTH + 2) // 3
N_B_LAYERS = (DEPTH + 1) // 3
N_C_LAYERS = DEPTH // 3
DEEPNORM_ALPHA = (2.0 * DEPTH) ** 0.25
DEEPNORM_BETA = (8.0 * DEPTH) ** -0.25
LN_EPS = 1e-6
RMS_EPS = 1e-6
NEG_INF = -1e30
ROPE_THETA = 10000.0
ATT_BLOCK = 128
MOD_SCALE = 0.5
S5_GROUP_CH = 16
S5_GROUPS = D_MODEL // S5_GROUP_CH
S5_STATE = 64
S5_DT_MIN = 0.001
S5_DT_MAX = 0.1
SCAN_CHUNK = 128
WINDOW = 128
HALO = ((WINDOW + ATT_BLOCK - 1) // ATT_BLOCK) * ATT_BLOCK
HEAD_DIM_B = 64
HEADS_B = D_MODEL // HEAD_DIM_B
KV_HEADS_B = 2
HEAD_DIM_C = 128
HEADS_C = D_MODEL // HEAD_DIM_C
KV_HEADS_C = 2
N_EXPERTS = 16
N_EXPERT_GROUPS = 4
EXPERTS_PER_GROUP = N_EXPERTS // N_EXPERT_GROUPS
TOP_K = 2
D_EXPERT = D_MODEL // 2

kernel_name = 'hybrid_s5_swa_axialgqa_moe_dit'


def _layer_norm(x, g, b):
    xf = x.astype(jnp.float32)
    xc = xf - xf.mean(-1, keepdims=True)
    var = jnp.mean(xc * xc, -1, keepdims=True)
    return (xc * lax.rsqrt(var + LN_EPS) * g.astype(jnp.float32) + b.astype(jnp.float32)).astype(x.dtype)


def _rms_norm(x, g):
    xf = x.astype(jnp.float32)
    return (xf * lax.rsqrt(jnp.mean(xf * xf, -1, keepdims=True) + RMS_EPS) * g.astype(jnp.float32)).astype(x.dtype)


def _modulation(cond, w, b):
    return jnp.split(jax.nn.silu(cond) @ w + b, 6, axis=-1)


def _axial_rope_tables(n_rows, head_dim):
    quarter = head_dim // 4
    inv_freq = ROPE_THETA ** (-jnp.arange(quarter, dtype=jnp.float32) / quarter)
    rows = jnp.repeat(jnp.arange(n_rows, dtype=jnp.float32), GRID_W)
    cols = jnp.tile(jnp.arange(GRID_W, dtype=jnp.float32), n_rows)
    ang = jnp.stack([rows[:, None] * inv_freq, cols[:, None] * inv_freq], axis=1)
    return jnp.cos(ang), jnp.sin(ang)


def _apply_axial_rope(x, cos, sin):
    Bsz, S, H, Dh = x.shape
    xr = x.reshape(Bsz, S, H, 2, 2, Dh // 4)
    x1, x2 = xr[..., 0, :], xr[..., 1, :]
    c = cos[None, :, None].astype(x.dtype)
    s = sin[None, :, None].astype(x.dtype)
    return jnp.stack([x1 * c - x2 * s, x2 * c + x1 * s], axis=-2).reshape(x.shape)


def _split_qkv(proj, n_heads, n_kv, head_dim):
    Bsz, L, _ = proj.shape
    q, k, v = jnp.split(proj, [n_heads * head_dim, (n_heads + n_kv) * head_dim], axis=-1)
    return (q.reshape(Bsz, L, n_heads, head_dim), k.reshape(Bsz, L, n_kv, head_dim),
            v.reshape(Bsz, L, n_kv, head_dim))


def _group_heads(q, n_kv):
    Bsz, L, H, Dh = q.shape
    return q.reshape(Bsz, L, n_kv, H // n_kv, Dh)


def _to_query_blocks(q, n_kv):
    Bsz, S, H, Dh = q.shape
    qb = q.reshape(Bsz, S // ATT_BLOCK, ATT_BLOCK, n_kv, H // n_kv, Dh)
    return qb.transpose(1, 0, 2, 3, 4, 5)


def _from_query_blocks(o):
    nb, Bsz, T, KV, R, Dh = o.shape
    return o.transpose(1, 0, 2, 3, 4, 5).reshape(Bsz, nb * T, KV * R * Dh)


def _attend(q, kv_groups, sink):
    scale = q.shape[-1] ** -0.5
    scores = []
    for k, v, mask in kv_groups:
        s = jnp.einsum('btkrd,blkd->bkrtl', q, k, preferred_element_type=jnp.float32) * scale
        if mask is not None:
            s = jnp.where(mask, s, NEG_INF)
        scores.append(s)
    m = functools.reduce(jnp.maximum, [s.max(-1, keepdims=True) for s in scores])
    if sink is not None:
        sink_logit = sink.astype(jnp.float32)[None, :, :, None, None]
        m = jnp.maximum(m, sink_logit)
    probs = [jnp.exp(s - m) for s in scores]
    denom = functools.reduce(jnp.add, [p.sum(-1, keepdims=True) for p in probs])
    if sink is not None:
        denom = denom + jnp.exp(sink_logit - m)
    inv = 1.0 / denom
    outs = [jnp.einsum('bkrtl,blkd->btkrd', (p * inv).astype(grp[1].dtype), grp[1])
            for p, grp in zip(probs, kv_groups)]
    return functools.reduce(jnp.add, outs)


def _complex_linear_combine(e1, e2):
    a1r, a1i, b1r, b1i = e1
    a2r, a2i, b2r, b2i = e2
    return (a2r * a1r - a2i * a1i, a2r * a1i + a2i * a1r,
            a2r * b1r - a2i * b1i + b2r, a2r * b1i + a2i * b1r + b2i)


def _s5_discretise(a_re, a_im, log_dt, b_re, b_im):
    f32 = jnp.float32
    a_re, a_im, b_re, b_im = a_re.astype(f32), a_im.astype(f32), b_re.astype(f32), b_im.astype(f32)
    dt = jnp.exp(log_dt.astype(f32))[:, None]
    mag = jnp.exp(a_re * dt)
    lam_re, lam_im = mag * jnp.cos(a_im * dt), mag * jnp.sin(a_im * dt)
    inv_den = 1.0 / (a_re * a_re + a_im * a_im)
    n_re = lam_re - 1.0
    f_re = (n_re * a_re + lam_im * a_im) * inv_den
    f_im = (lam_im * a_re - n_re * a_im) * inv_den
    bb_re = f_re[..., None] * b_re - f_im[..., None] * b_im
    bb_im = f_re[..., None] * b_im + f_im[..., None] * b_re
    return lam_re, lam_im, bb_re, bb_im


def _s5_scan(u, h0_re, h0_im, lam_re, lam_im, bb_re, bb_im, c_re, c_im, with_output):
    Bsz, L, G, GC = u.shape
    n_chunks = L // SCAN_CHUNK
    u_chunks = u.reshape(Bsz, n_chunks, SCAN_CHUNK, G, GC).transpose(1, 2, 0, 3, 4)
    lam_t_re = jnp.broadcast_to(lam_re, (SCAN_CHUNK, 1) + lam_re.shape)
    lam_t_im = jnp.broadcast_to(lam_im, (SCAN_CHUNK, 1) + lam_im.shape)

    def chunk_step(carry, u_blk):
        h_re, h_im = carry
        x_re = jnp.einsum('tbgc,gpc->tbgp', u_blk, bb_re)
        x_im = jnp.einsum('tbgc,gpc->tbgp', u_blk, bb_im)
        p_re, p_im, s_re, s_im = lax.associative_scan(
            _complex_linear_combine, (lam_t_re, lam_t_im, x_re, x_im), axis=0)
        s_re, s_im = (s_re + p_re * h_re - p_im * h_im, s_im + p_re * h_im + p_im * h_re)
        y = None
        if with_output:
            y = jnp.einsum('tbgp,gcp->tbgc', s_re, c_re) - jnp.einsum('tbgp,gcp->tbgc', s_im, c_im)
        return (s_re[-1], s_im[-1]), y

    (h_re, h_im), y = lax.scan(chunk_step, (h0_re, h0_im), u_chunks)
    if with_output:
        y = y.transpose(2, 0, 1, 3, 4).reshape(Bsz, L, G * GC)
    return y, h_re, h_im


def _s5_mixer(h_lat, h_ctx, a_re, a_im, log_dt, b_re, b_im, c_re, c_im, d_skip, w_gate, w_val, ctx_out):
    f32 = jnp.float32
    Bsz, S, D = h_lat.shape
    n_ctx = h_ctx.shape[1]
    u_lat = h_lat.astype(f32).reshape(Bsz, S, S5_GROUPS, S5_GROUP_CH)
    u_ctx = h_ctx.astype(f32).reshape(Bsz, n_ctx, S5_GROUPS, S5_GROUP_CH)
    zero = jnp.zeros((Bsz, S5_GROUPS, S5_STATE), f32)
    y_lat = d_skip.astype(f32) * h_lat.astype(f32)
    y_ctx = d_skip.astype(f32) * h_ctx.astype(f32) if ctx_out else None
    for direction in range(2):
        flip = (lambda t: t[:, ::-1]) if direction == 1 else (lambda t: t)
        lam_re, lam_im, bb_re, bb_im = _s5_discretise(
            a_re[direction], a_im[direction], log_dt[direction], b_re[direction], b_im[direction])
        cr, ci = c_re[direction].astype(f32), c_im[direction].astype(f32)
        yc, hc_re, hc_im = _s5_scan(flip(u_ctx), zero, zero, lam_re, lam_im, bb_re, bb_im, cr, ci, ctx_out)
        yl, _, _ = _s5_scan(flip(u_lat), hc_re, hc_im, lam_re, lam_im, bb_re, bb_im, cr, ci, True)
        y_lat = y_lat + flip(yl)
        if ctx_out:
            y_ctx = y_ctx + flip(yc)

    def glu(y, dtype):
        g = jax.nn.gelu(y.astype(dtype))
        return (g @ w_val) * jax.nn.sigmoid(g @ w_gate)

    out_lat = glu(y_lat, h_lat.dtype)
    out_ctx = glu(y_ctx, h_ctx.dtype) if ctx_out else None
    return out_lat, out_ctx


def _windowed_gqa(h_lat, h_ctx, w_qkv, w_o, sink, cos, sin, ctx_out):
    Bsz, S, _ = h_lat.shape
    n_ctx = h_ctx.shape[1]
    q, k, v = _split_qkv(h_lat @ w_qkv, HEADS_B, KV_HEADS_B, HEAD_DIM_B)
    q, k = _apply_axial_rope(q, cos, sin), _apply_axial_rope(k, cos, sin)
    qc, kc, vc = _split_qkv(h_ctx @ w_qkv, HEADS_B, KV_HEADS_B, HEAD_DIM_B)
    sink_g = sink.reshape(KV_HEADS_B, HEADS_B // KV_HEADS_B)
    pad = ((0, 0), (HALO, HALO), (0, 0), (0, 0))
    kp, vp = jnp.pad(k, pad), jnp.pad(v, pad)
    band = ATT_BLOCK + 2 * HALO
    qi = jnp.arange(ATT_BLOCK)[:, None]
    kj = jnp.arange(band)[None, :]
    in_window = jnp.abs(kj - HALO - qi) <= WINDOW

    def one_block(args):
        b, q_blk = args
        start = b * ATT_BLOCK
        k_blk = lax.dynamic_slice_in_dim(kp, start, band, axis=1)
        v_blk = lax.dynamic_slice_in_dim(vp, start, band, axis=1)
        key_pos = start - HALO + kj
        mask = in_window & (key_pos >= 0) & (key_pos < S)
        return _attend(q_blk, ((k_blk, v_blk, mask), (kc, vc, None)), sink_g)

    o = lax.map(one_block, (jnp.arange(S // ATT_BLOCK), _to_query_blocks(q, KV_HEADS_B)))
    y_lat = _from_query_blocks(o) @ w_o
    y_ctx = None
    if ctx_out:
        o_c = _attend(_group_heads(qc, KV_HEADS_B), ((kc, vc, None),), sink_g)
        y_ctx = o_c.reshape(Bsz, n_ctx, HEADS_B * HEAD_DIM_B) @ w_o
    return y_lat, y_ctx


def _axial_gqa(h_lat, h_ctx, w_qkv, w_o, q_norm, k_norm, cos, sin, ctx_out):
    Bsz, S, _ = h_lat.shape
    n_ctx = h_ctx.shape[1]
    q, k, v = _split_qkv(h_lat @ w_qkv, HEADS_C, KV_HEADS_C, HEAD_DIM_C)
    q = _apply_axial_rope(_rms_norm(q, q_norm), cos, sin)
    k = _apply_axial_rope(_rms_norm(k, k_norm), cos, sin)
    qc, kc, vc = _split_qkv(h_ctx @ w_qkv, HEADS_C, KV_HEADS_C, HEAD_DIM_C)
    kc = _rms_norm(kc, k_norm)

    def one_block(q_blk):
        return _attend(q_blk, ((k, v, None), (kc, vc, None)), None)

    o = lax.map(one_block, _to_query_blocks(q, KV_HEADS_C))
    y_lat = _from_query_blocks(o) @ w_o
    y_ctx = None
    if ctx_out:
        o_c = _attend(_group_heads(_rms_norm(qc, q_norm), KV_HEADS_C), ((kc, vc, None),), None)
        y_ctx = o_c.reshape(Bsz, n_ctx, HEADS_C * HEAD_DIM_C) @ w_o
    return y_lat, y_ctx


def _moe(h, router_w, router_b, w1, w3, w2):
    n_tok = h.shape[0]
    aff = jax.nn.sigmoid((h @ router_w).astype(jnp.float32))
    sel = aff + router_b.astype(jnp.float32)
    group_score = lax.top_k(sel.reshape(n_tok, N_EXPERT_GROUPS, EXPERTS_PER_GROUP), TOP_K)[0].sum(-1)
    group = jnp.argmax(group_score, axis=-1)
    expert_group = jnp.arange(N_EXPERTS) // EXPERTS_PER_GROUP
    masked = jnp.where(expert_group[None, :] == group[:, None], sel, NEG_INF)
    _, idx = lax.top_k(masked, TOP_K)
    gate = jnp.take_along_axis(aff, idx, axis=-1)
    gate = gate / gate.sum(-1, keepdims=True)
    combine = jnp.einsum('nk,nke->ne', gate, jax.nn.one_hot(idx, N_EXPERTS, dtype=jnp.float32)).astype(h.dtype)
    y = jnp.zeros_like(h)
    for e in range(N_EXPERTS):
        out = (jax.nn.silu(h @ w1[e]) * (h @ w3[e])) @ w2[e]
        y = y + combine[:, e:e + 1] * out
    return y


def setup_inputs(seed: int = 0) -> dict:
    key = jax.random.key(seed)
    ks = iter(jax.random.split(key, 40))
    f32 = jnp.float32

    def nrm(shape, scale):
        return scale * jax.random.normal(next(ks), shape, f32)

    D = D_MODEL
    qkv_b = (HEADS_B + 2 * KV_HEADS_B) * HEAD_DIM_B
    qkv_c = (HEADS_C + 2 * KV_HEADS_C) * HEAD_DIM_C
    s5_shape = (N_A_LAYERS, 2, S5_GROUPS, S5_STATE)
    return {
        'x': nrm((BATCH, SEQ, D), 1.0),
        'c': nrm((BATCH, D), 1.0),
        'ctx': nrm((BATCH, CTX_LEN, D), 1.0),
        'c_ctx': nrm((D,), 1.0),
        'mod_w': nrm((DEPTH, D, 6 * D), MOD_SCALE * D ** -0.5),
        'mod_b': nrm((DEPTH, 6 * D), 0.02),
        'ln_g': 1.0 + nrm((DEPTH, 2, D), 0.02),
        'ln_b': nrm((DEPTH, 2, D), 0.02),
        'router_w': nrm((D, N_EXPERTS), D ** -0.5),
        'router_b': nrm((N_EXPERTS,), 0.01),
        'moe_w1': nrm((DEPTH, N_EXPERTS, D, D_EXPERT), D ** -0.5),
        'moe_w3': nrm((DEPTH, N_EXPERTS, D, D_EXPERT), D ** -0.5),
        'moe_w2': nrm((DEPTH, N_EXPERTS, D_EXPERT, D), DEEPNORM_BETA * D_EXPERT ** -0.5),
        's5_a_re': -0.5 + nrm(s5_shape, 0.01),
        's5_a_im': jnp.pi * jnp.arange(S5_STATE, dtype=f32) + nrm(s5_shape, 0.01),
        's5_log_dt': jax.random.uniform(next(ks), (N_A_LAYERS, 2, S5_GROUPS), f32,
                                        math.log(S5_DT_MIN), math.log(S5_DT_MAX)),
        's5_b_re': nrm((N_A_LAYERS, 2, S5_GROUPS, S5_STATE, S5_GROUP_CH), (2 * S5_GROUP_CH) ** -0.5),
        's5_b_im': nrm((N_A_LAYERS, 2, S5_GROUPS, S5_STATE, S5_GROUP_CH), (2 * S5_GROUP_CH) ** -0.5),
        's5_c_re': nrm((N_A_LAYERS, 2, S5_GROUPS, S5_GROUP_CH, S5_STATE), 0.5 ** 0.5),
        's5_c_im': nrm((N_A_LAYERS, 2, S5_GROUPS, S5_GROUP_CH, S5_STATE), 0.5 ** 0.5),
        's5_d': nrm((N_A_LAYERS, D), 1.0),
        's5_w_gate': nrm((N_A_LAYERS, D, D), D ** -0.5),
        's5_w_val': nrm((N_A_LAYERS, D, D), DEEPNORM_BETA * D ** -0.5),
        'swa_w_qkv': nrm((N_B_LAYERS, D, qkv_b), D ** -0.5),
        'swa_w_o': nrm((N_B_LAYERS, HEADS_B * HEAD_DIM_B, D), DEEPNORM_BETA * D ** -0.5),
        'swa_sink': nrm((N_B_LAYERS, HEADS_B), 1.0),
        'gqa_w_qkv': nrm((N_C_LAYERS, D, qkv_c), D ** -0.5),
        'gqa_w_o': nrm((N_C_LAYERS, HEADS_C * HEAD_DIM_C, D), DEEPNORM_BETA * D ** -0.5),
        'gqa_q_norm': 1.0 + nrm((N_C_LAYERS, HEAD_DIM_C), 0.02),
        'gqa_k_norm': 1.0 + nrm((N_C_LAYERS, HEAD_DIM_C), 0.02),
    }


def reference(x, c, ctx, c_ctx, mod_w, mod_b, ln_g, ln_b, router_w, router_b,
              moe_w1, moe_w3, moe_w2,
              s5_a_re, s5_a_im, s5_log_dt, s5_b_re, s5_b_im, s5_c_re, s5_c_im, s5_d, s5_w_gate, s5_w_val,
              swa_w_qkv, swa_w_o, swa_sink,
              gqa_w_qkv, gqa_w_o, gqa_q_norm, gqa_k_norm):
    Bsz, S, D = x.shape
    n_ctx = ctx.shape[1]
    n_rows = S // GRID_W
    cos_b, sin_b = _axial_rope_tables(n_rows, HEAD_DIM_B)
    cos_c, sin_c = _axial_rope_tables(n_rows, HEAD_DIM_C)
    for i in range(DEPTH):
        kind, j = i % N_MIXERS, i // N_MIXERS
        ctx_out = i < DEPTH - 1
        sh1, sc1, g1, sh2, sc2, g2 = [t[:, None, :] for t in _modulation(c, mod_w[i], mod_b[i])]
        csh1, csc1, cg1, csh2, csc2, cg2 = _modulation(c_ctx, mod_w[i], mod_b[i])
        h_lat = x * (1 + sc1) + sh1
        h_ctx = ctx * (1 + csc1) + csh1
        if kind == 0:
            y_lat, y_ctx = _s5_mixer(h_lat, h_ctx, s5_a_re[j], s5_a_im[j], s5_log_dt[j], s5_b_re[j], s5_b_im[j],
                                     s5_c_re[j], s5_c_im[j], s5_d[j], s5_w_gate[j], s5_w_val[j], ctx_out)
        elif kind == 1:
            y_lat, y_ctx = _windowed_gqa(h_lat, h_ctx, swa_w_qkv[j], swa_w_o[j], swa_sink[j], cos_b, sin_b, ctx_out)
        else:
            y_lat, y_ctx = _axial_gqa(h_lat, h_ctx, gqa_w_qkv[j], gqa_w_o[j], gqa_q_norm[j], gqa_k_norm[j],
                                      cos_c, sin_c, ctx_out)
        x = _layer_norm(DEEPNORM_ALPHA * x + g1 * y_lat, ln_g[i, 0], ln_b[i, 0])
        h_lat = x * (1 + sc2) + sh2
        if ctx_out:
            ctx = _layer_norm(DEEPNORM_ALPHA * ctx + cg1 * y_ctx, ln_g[i, 0], ln_b[i, 0])
            h_ctx = ctx * (1 + csc2) + csh2
            tokens = jnp.concatenate([h_ctx, h_lat], axis=1).reshape(-1, D)
            y = _moe(tokens, router_w, router_b, moe_w1[i], moe_w3[i], moe_w2[i]).reshape(Bsz, n_ctx + S, D)
            ctx = _layer_norm(DEEPNORM_ALPHA * ctx + cg2 * y[:, :n_ctx], ln_g[i, 1], ln_b[i, 1])
            y_lat = y[:, n_ctx:]
        else:
            y_lat = _moe(h_lat.reshape(-1, D), router_w, router_b, moe_w1[i], moe_w3[i], moe_w2[i]).reshape(Bsz, S, D)
        x = _layer_norm(DEEPNORM_ALPHA * x + g2 * y_lat, ln_g[i, 1], ln_b[i, 1])
    return x
```

```cpp
#include <hip/hip_runtime.h>
#include <cstdio>
#include <cstdint>
__device__ __forceinline__ int hw_lane() { int l; asm volatile("v_mbcnt_lo_u32_b32 %0, -1, 0\n\tv_mbcnt_hi_u32_b32 %0, -1, %0" : "=v"(l)); return l; }
#define HW_TID(w0) ((w0) * 64 + hw_lane())
namespace pg8 {
#define PG8_LAS __attribute__((address_space(3)))
typedef unsigned short bf16_t;
typedef short bf16x8 __attribute__((ext_vector_type(8)));
typedef float f32x4 __attribute__((ext_vector_type(4)));
typedef unsigned u32x4 __attribute__((ext_vector_type(4)));
constexpr int BM = 256, BK = 64, HALF = 128, HTB = HALF * BK * 2  , STAGE_BYTES = 8 * HTB, NXCD = 8, WGM = 8;

__host__ __device__ __forceinline__ int lds_byte(int r, int c) { const int st = (r >> 4) * 2 + (c >> 5), rr = r & 15, cc = c & 31, ob = rr * 64 + cc * 2; return st * 1024 + (ob ^ (((ob >> 9) & 1) << 5)); }
__host__ __device__ __forceinline__ void stage_rc(int b, int& R, int& C) { const int st = b / 1024, sb = b % 1024, swz = sb ^ (((sb >> 9) & 1) << 5); R = (st >> 1) * 16 + swz / 64; C = (st & 1) * 32 + (swz % 64) / 2; }
__host__ __device__ __forceinline__ int perm32(int rho) { const int n = rho >> 4, i = rho & 15; return 8 * (i >> 2) + 4 * n + (i & 3); }

struct Unit { int pm, pn; };
struct Gemm { const bf16_t* A; const bf16_t* Bt; int M, N, K; const int* pe; size_t bstride; const int* rowmap; };

struct StaticOrder {
    int nM, nN, nwg, G, c, lim;
    __host__ __device__ void init(int M, int N, int G_, int c_) { nM = M / BM; nN = N / BM; nwg = nM * nN; G = G_; c = c_; lim = nwg; }
    __host__ __device__ void at(int L, Unit& u) const {
        int wgid = L; { const int q = nwg / NXCD, r = nwg % NXCD, xcd = wgid % NXCD, off = wgid / NXCD; wgid = (xcd < r ? xcd * (q + 1) : r * (q + 1) + (xcd - r) * q) + off; }
        const int nig = WGM * nN, gid = wgid / nig, fm = gid * WGM, gsz = (nM - fm) < WGM ? (nM - fm) : WGM;
        u.pm = fm + ((wgid % nig) % gsz); u.pn = (wgid % nig) / gsz;
    }
    __host__ __device__ bool next(int i, Unit& u) const {
        const long L = (long)i * G + c; if (L >= lim) return false;
        at((int)L, u); return true;
    }
    __device__ __forceinline__ void a_ready(const Unit&) const {}
    __device__ __forceinline__ void done(const Unit&) const {}
};

struct LatOrder {
    StaticOrder S;
    __host__ __device__ void init(int N, int G_, int c_) { S.init(128 * BM, N, G_, c_); }
    __host__ __device__ bool next(int i, Unit& u) const { if (!S.next(i, u)) return false; u.pm = u.pm + 1 + (u.pm >> 6); return true; }
    __device__ __forceinline__ void a_ready(const Unit&) const {}
    __device__ __forceinline__ void done(const Unit&) const {}
};

__device__ __forceinline__ unsigned cvt_pk_bf16(float lo, float hi) { unsigned r; asm volatile("v_cvt_pk_bf16_f32 %0, %1, %2" : "=v"(r) : "v"(lo), "v"(hi)); return r; }
typedef float f32x2 __attribute__((ext_vector_type(2)));
__device__ __forceinline__ f32x2 gelu_pk(f32x2 v) {
    const f32x2 av = __builtin_elementwise_abs(v), d = av * 0.2316418882f + 1.0f;
    f32x2 t; t.x = __builtin_amdgcn_rcpf(d.x); t.y = __builtin_amdgcn_rcpf(d.y);
    f32x2 q = t * 0.5307027145f + (-0.7265760135f); q = q * t + 0.7107068705f; q = q * t + (-0.142248368f); q = q * t + 0.127414796f; q = q * t;
    const f32x2 s = (v * v) * (-0.72134752044f);
    f32x2 e; e.x = __builtin_amdgcn_exp2f(s.x); e.y = __builtin_amdgcn_exp2f(s.y);
    const f32x2 m = v * (q * e), r = v - m;
    f32x2 o; o.x = v.x < 0.f ? m.x : r.x; o.y = v.y < 0.f ? m.y : r.y; return o;
}

template <int ACT  > struct EpiBf16 {
    static constexpr bool PERM = true, AFTER_DRAIN = false; static_assert(ACT == 0 || ACT == 1, "EpiBf16: ACT is 0 (none) or 1 (gelu_pk)");
    bf16_t* O; int ldc; const float* bias; int split_cols; size_t split_stride; float scale0;
    __device__ __forceinline__ void operator()(const f32x4 (&acc)[2][2][4][2], const Unit& u, int wr, int wc, int fr, int fq) const {
        const int row0 = u.pm * BM + wr * 64 + fr; int colt = u.pn * BM; bf16_t* base = O;
        float sc = 1.f; if (split_cols) { const int t = colt / split_cols; base += (size_t)t * split_stride; colt -= t * split_cols; if (t == 0) sc = scale0; }
        const int col0 = colt + wc * 32 + 8 * fq, bcol0 = u.pn * BM + wc * 32 + 8 * fq;
        f32x4 bv[2][2];
#pragma unroll
        for (int bj = 0; bj < 2; ++bj)
#pragma unroll
            for (int n = 0; n < 2; ++n) bv[bj][n] = bias ? *(const f32x4*)(bias + bcol0 + bj * HALF + 4 * n) : (f32x4){0.f, 0.f, 0.f, 0.f};
#pragma unroll
        for (int ai = 0; ai < 2; ++ai)
#pragma unroll
            for (int m = 0; m < 4; ++m) { bf16_t* rowp = base + (size_t)(row0 + ai * HALF + m * 16) * ldc + col0;
#pragma unroll
                for (int bj = 0; bj < 2; ++bj) { f32x4 v0 = acc[ai][bj][m][0] + bv[bj][0], v1 = acc[ai][bj][m][1] + bv[bj][1];
                    if (ACT == 1) { f32x2 a = gelu_pk((f32x2){v0[0], v0[1]}), b = gelu_pk((f32x2){v0[2], v0[3]}), c = gelu_pk((f32x2){v1[0], v1[1]}), d = gelu_pk((f32x2){v1[2], v1[3]});
                        v0 = (f32x4){a.x, a.y, b.x, b.y}; v1 = (f32x4){c.x, c.y, d.x, d.y}; }
                    v0 = v0 * sc; v1 = v1 * sc; u32x4 w; w.x = cvt_pk_bf16(v0[0], v0[1]); w.y = cvt_pk_bf16(v0[2], v0[3]); w.z = cvt_pk_bf16(v1[0], v1[1]); w.w = cvt_pk_bf16(v1[2], v1[3]);
                    *(u32x4*)(rowp + bj * HALF) = w; } }
    }
};


__device__ __forceinline__ float sigmoidf_fast(float x) { return __builtin_amdgcn_rcpf(1.0f + __builtin_amdgcn_exp2f(-1.4426950408889634f * x)); }
struct EpiGlu {
    static constexpr bool PERM = true, AFTER_DRAIN = false;
    bf16_t* O; int ldc;
    __device__ __forceinline__ void operator()(const f32x4 (&acc)[2][2][4][2], const Unit& u, int wr, int wc, int fr, int fq) const {
        const int row0 = u.pm * BM + wr * 64 + fr, col0 = u.pn * HALF + wc * 32 + 8 * fq;
#pragma unroll
        for (int ai = 0; ai < 2; ++ai)
#pragma unroll
            for (int m = 0; m < 4; ++m) { bf16_t* rowp = O + (size_t)(row0 + ai * HALF + m * 16) * ldc + col0;
                float o[8];
#pragma unroll
                for (int n = 0; n < 2; ++n)
#pragma unroll
                    for (int j = 0; j < 4; ++j) o[4 * n + j] = acc[ai][0][m][n][j] * sigmoidf_fast(acc[ai][1][m][n][j]);
                u32x4 w; w.x = cvt_pk_bf16(o[0], o[1]); w.y = cvt_pk_bf16(o[2], o[3]); w.z = cvt_pk_bf16(o[4], o[5]); w.w = cvt_pk_bf16(o[6], o[7]);
                *(u32x4*)rowp = w; }
    }
};
struct EpiRopeB {
    static constexpr bool PERM = true, AFTER_DRAIN = false;
    bf16_t* O; int ldc; const float* cosT; const float* sinT; int rope_cols;
    __device__ __forceinline__ void operator()(const f32x4 (&acc)[2][2][4][2], const Unit& u, int wr, int wc, int fr, int fq) const {
        const int row0 = u.pm * BM + wr * 64 + fr, col0 = u.pn * BM + wc * 32 + 8 * fq;
        const int pbk = u.pm % 65, t0 = (pbk - 1) * BM + wr * 64 + fr;
        const int i0 = 8 * (fq & 1); const bool second = fq >= 2;
#pragma unroll
        for (int ai = 0; ai < 2; ++ai)
#pragma unroll
            for (int m = 0; m < 4; ++m) { const int t = t0 + ai * HALF + m * 16, pos = (wc & 1) ? (t & 63) : (t >> 6);
                const f32x4 c0 = *(const f32x4*)(cosT + pos * 16 + i0), c1 = *(const f32x4*)(cosT + pos * 16 + i0 + 4), s0 = *(const f32x4*)(sinT + pos * 16 + i0), s1 = *(const f32x4*)(sinT + pos * 16 + i0 + 4);
                bf16_t* rowp = O + (size_t)(row0 + ai * HALF + m * 16) * ldc + col0;
#pragma unroll
                for (int bj = 0; bj < 2; ++bj) { f32x4 v0 = acc[ai][bj][m][0], v1 = acc[ai][bj][m][1];
                    if (u.pn * BM + bj * HALF < rope_cols) {
                        f32x4 p0, p1;
#pragma unroll
                        for (int j = 0; j < 4; ++j) { p0[j] = __shfl_xor(v0[j], 32); p1[j] = __shfl_xor(v1[j], 32); }
                        v0 = second ? v0 * c0 + p0 * s0 : v0 * c0 - p0 * s0; v1 = second ? v1 * c1 + p1 * s1 : v1 * c1 - p1 * s1; }
                    u32x4 w; w.x = cvt_pk_bf16(v0[0], v0[1]); w.y = cvt_pk_bf16(v0[2], v0[3]); w.z = cvt_pk_bf16(v1[0], v1[1]); w.w = cvt_pk_bf16(v1[2], v1[3]);
                    *(u32x4*)(rowp + bj * HALF) = w; } }
    }
};
struct EpiSwiglu {
    static constexpr bool PERM = true, AFTER_DRAIN = false;
    bf16_t* O; int ldc; const float* gate;
    __device__ __forceinline__ void operator()(const f32x4 (&acc)[2][2][4][2], const Unit& u, int wr, int wc, int fr, int fq) const {
        const int row0 = u.pm * BM + wr * 64 + fr, col0 = u.pn * HALF + wc * 32 + 8 * fq;
        float gwv[2][4];
#pragma unroll
        for (int ai = 0; ai < 2; ++ai)
#pragma unroll
            for (int m = 0; m < 4; ++m) gwv[ai][m] = gate[row0 + ai * HALF + m * 16];
#pragma unroll
        for (int ai = 0; ai < 2; ++ai)
#pragma unroll
            for (int m = 0; m < 4; ++m) { const int row = row0 + ai * HALF + m * 16; bf16_t* rowp = O + (size_t)row * ldc + col0; const float gw = gwv[ai][m];
                float o[8];
#pragma unroll
                for (int n = 0; n < 2; ++n)
#pragma unroll
                    for (int j = 0; j < 4; ++j) { const float a1 = acc[ai][0][m][n][j]; o[4 * n + j] = a1 * sigmoidf_fast(a1) * acc[ai][1][m][n][j] * gw; }
                u32x4 w; w.x = cvt_pk_bf16(o[0], o[1]); w.y = cvt_pk_bf16(o[2], o[3]); w.z = cvt_pk_bf16(o[4], o[5]); w.w = cvt_pk_bf16(o[6], o[7]);
                *(u32x4*)rowp = w; }
    }
};
template <class Epi, class Sched, bool ALIGN_EPI = false, bool SP2 = false, bool GATHER = false>
__device__ __forceinline__ void gemm_phase(PG8_LAS unsigned char* lds, const Gemm g, const Sched& S, const Epi& E, int tid_in) {
    int tid_l = tid_in; asm volatile("" : "+v"(tid_l));
    const int tid = tid_l, wid = __builtin_amdgcn_readfirstlane(tid >> 6), lane = tid & 63, wr = wid >> 2, wc = wid & 3, fr = lane & 15, fq = lane >> 4;
    const int K = g.K, nt = K / BK;
    unsigned voffA[2], voffB[2];
#pragma unroll
    for (int i = 0; i < 2; ++i) { int R, C; stage_rc(tid * 16 + i * 8192, R, C); const int Rb = Epi::PERM ? ((R & ~31) + perm32(R & 31)) : R;
        voffA[i] = (unsigned)(R * K + C) * 2u; voffB[i] = (unsigned)(Rb * K + C) * 2u; }
    static_assert(!GATHER || SP2, "GATHER is wired into the SP2 loop only");
    int gR[2], gC[2]; unsigned voffAc[2][2], voffAn[2][2];
#pragma unroll
    for (int i = 0; i < 2; ++i) { int R, C; stage_rc(tid * 16 + i * 8192, R, C); gR[i] = R; gC[i] = C * 2; }
#define PG8_GVOFF(dst, pm_) do { if constexpr (GATHER) { _Pragma("unroll") for (int hh_ = 0; hh_ < 2; ++hh_) _Pragma("unroll") for (int i_ = 0; i_ < 2; ++i_) \
        dst[hh_][i_] = (unsigned)g.rowmap[(pm_) * BM + hh_ * HALF + gR[i_]] * (unsigned)(K * 2) + (unsigned)gC[i_]; } } while (0)
#define PG8_STAGE_A(bufoff, gbase, hh, nf) do { if constexpr (GATHER) { const unsigned o0_ = (nf) ? voffAn[hh][0] : voffAc[hh][0], o1_ = (nf) ? voffAn[hh][1] : voffAc[hh][1]; \
        __builtin_amdgcn_global_load_lds((const unsigned*)((const char*)(gbase) + o0_), (PG8_LAS unsigned*)(lds + (bufoff) + ldsw), 16, 0, 0); \
        __builtin_amdgcn_global_load_lds((const unsigned*)((const char*)(gbase) + o1_), (PG8_LAS unsigned*)(lds + (bufoff) + ldsw + 8192), 16, 0, 0); } \
      else { PG8_STAGE(bufoff, (gbase) + (hh) * hstep, voffA); } } while (0)
    const size_t kstep = (size_t)(BK * 2);
    const size_t hstep = (size_t)HALF * K * 2;
    const size_t tstep = 2 * hstep;
    const unsigned ldsw = (unsigned)wid * 1024u;
    const int aoff = lds_byte(wr * 64 + fr, fq * 8), boff = lds_byte(wc * 32 + fr, fq * 8);
#define PG8_SA(b, h) (((b) * 2 + (h)) * HTB)
#define PG8_SB(b, h) ((4 + (b) * 2 + (h)) * HTB)
#define PG8_STAGE(bufoff, gbase, voff) do { _Pragma("unroll") for (int _i = 0; _i < 2; ++_i) \
        __builtin_amdgcn_global_load_lds((const unsigned*)((const char*)(gbase) + (voff)[_i]), (PG8_LAS unsigned*)(lds + (bufoff) + ldsw + _i * 8192), 16, 0, 0); } while (0)
#define PG8_LDA(dst, b, h) do { _Pragma("unroll") for (int m = 0; m < 4; ++m) _Pragma("unroll") for (int k = 0; k < 2; ++k) dst[m][k] = *(const PG8_LAS bf16x8*)(lds + PG8_SA(b, h) + aoff + m * 2048 + k * 1024); } while (0)
#define PG8_LDB(dst, b, h) do { _Pragma("unroll") for (int n = 0; n < 2; ++n) _Pragma("unroll") for (int k = 0; k < 2; ++k) dst[n][k] = *(const PG8_LAS bf16x8*)(lds + PG8_SB(b, h) + boff + n * 2048 + k * 1024); } while (0)
#define PG8_MMA(ai, bj, At, Bt) do { __builtin_amdgcn_s_setprio(1); _Pragma("unroll") for (int m = 0; m < 4; ++m) _Pragma("unroll") for (int n = 0; n < 2; ++n) _Pragma("unroll") for (int k = 0; k < 2; ++k) \
        acc[ai][bj][m][n] = __builtin_amdgcn_mfma_f32_16x16x32_bf16(Bt[n][k], At[m][k], acc[ai][bj][m][n], 0, 0, 0); __builtin_amdgcn_s_setprio(0); } while (0)
#define PG8_WAIT_V(n) asm volatile("s_waitcnt vmcnt(" #n ")" ::: "memory")
#define PG8_WAIT_L(n) asm volatile("s_waitcnt lgkmcnt(" #n ")" ::: "memory")
#define PG8_BAR __builtin_amdgcn_s_barrier()
#define PG8_SCHED __builtin_amdgcn_sched_barrier(0)
    Unit cur, nxt; int ui = 0;
    if (!S.next(0, cur)) return;
    f32x4 acc[2][2][4][2];
#pragma unroll
    for (int a = 0; a < 2; ++a)
#pragma unroll
        for (int b = 0; b < 2; ++b)
#pragma unroll
            for (int m = 0; m < 4; ++m)
#pragma unroll
                for (int n = 0; n < 2; ++n) acc[a][b][m][n] = (f32x4){0.f, 0.f, 0.f, 0.f};
    bf16x8 At[4][2], B0[2][2], B1[2][2];
    const char* cA = GATHER ? (const char*)g.A : (const char*)g.A + (size_t)cur.pm * tstep; PG8_GVOFF(voffAc, cur.pm); const char* cB = (const char*)g.Bt + (size_t)cur.pn * tstep + (g.pe ? (size_t)g.pe[cur.pm] * g.bstride : (size_t)0);
    S.a_ready(cur);
    if constexpr (SP2) {
        PG8_STAGE(PG8_SB(0, 0), cB, voffB); PG8_STAGE(PG8_SB(0, 1), cB + hstep, voffB); PG8_STAGE_A(PG8_SA(0, 0), cA, 0, false); PG8_STAGE_A(PG8_SA(0, 1), cA, 1, false);
        if (wr == 1) PG8_BAR;
        PG8_WAIT_V(2); PG8_BAR;
        PG8_STAGE(PG8_SB(1, 0), cB + kstep, voffB); PG8_STAGE_A(PG8_SA(1, 0), cA + kstep, 0, false); PG8_STAGE(PG8_SB(1, 1), cB + hstep + kstep, voffB);
        PG8_WAIT_V(6); PG8_BAR;
    } else {
        PG8_STAGE(PG8_SB(0, 0), cB, voffB); PG8_STAGE(PG8_SA(0, 0), cA, voffA); PG8_STAGE(PG8_SB(0, 1), cB + hstep, voffB); PG8_STAGE(PG8_SA(0, 1), cA + hstep, voffA);
        if (wr == 1) PG8_BAR;
        PG8_WAIT_V(4); PG8_BAR;
        PG8_STAGE(PG8_SB(1, 0), cB + kstep, voffB); PG8_STAGE(PG8_SA(1, 0), cA + kstep, voffA); PG8_STAGE(PG8_SB(1, 1), cB + hstep + kstep, voffB);
        PG8_WAIT_V(6); PG8_BAR;
    }
    for (;;) {
        const bool has_next = S.next(ui + 1, nxt);
        const char* nA = GATHER ? cA : (has_next ? (const char*)g.A + (size_t)nxt.pm * tstep : cA);
        if constexpr (GATHER) { if (has_next) PG8_GVOFF(voffAn, nxt.pm); else { _Pragma("unroll") for (int hh_ = 0; hh_ < 2; ++hh_) _Pragma("unroll") for (int i_ = 0; i_ < 2; ++i_) voffAn[hh_][i_] = voffAc[hh_][i_]; } } const char* nB = has_next ? (const char*)g.Bt + (size_t)nxt.pn * tstep + (g.pe ? (size_t)g.pe[nxt.pm] * g.bstride : (size_t)0) : cB;
        for (int t = 0; t < nt; t += 2) {
            const bool last = (t == nt - 2);
            const char* a1 = cA + (size_t)(t + 1) * kstep;
            const char* a2 = last ? nA : cA + (size_t)(t + 2) * kstep; const char* b2 = last ? nB : cB + (size_t)(t + 2) * kstep;
            const char* a3 = a2 + kstep; const char* b3 = b2 + kstep;
            if (last && has_next) S.a_ready(nxt);
            if constexpr (SP2) {
            PG8_LDB(B0, 0, 0); PG8_LDB(B1, 0, 1); PG8_SCHED; PG8_LDA(At, 0, 0); PG8_STAGE_A(PG8_SA(1, 1), a1, 1, false);
            PG8_WAIT_V(8); PG8_WAIT_L(0); PG8_BAR; PG8_MMA(0, 0, At, B0); PG8_MMA(0, 1, At, B1); PG8_BAR; PG8_SCHED;
            PG8_LDA(At, 0, 1); PG8_STAGE(PG8_SB(0, 0), b2, voffB); PG8_STAGE(PG8_SB(0, 1), b2 + hstep, voffB); PG8_STAGE_A(PG8_SA(0, 0), a2, 0, last);
            PG8_WAIT_V(8); PG8_WAIT_L(0); PG8_BAR; PG8_MMA(1, 0, At, B0); PG8_MMA(1, 1, At, B1); PG8_BAR; PG8_SCHED;
            PG8_LDB(B0, 1, 0); PG8_LDB(B1, 1, 1); PG8_SCHED; PG8_LDA(At, 1, 0); PG8_STAGE_A(PG8_SA(0, 1), a2, 1, last);
            PG8_WAIT_V(8); PG8_WAIT_L(0); PG8_BAR; PG8_MMA(0, 0, At, B0); PG8_MMA(0, 1, At, B1); PG8_BAR; PG8_SCHED;
            PG8_LDA(At, 1, 1); PG8_STAGE(PG8_SB(1, 0), b3, voffB); PG8_STAGE(PG8_SB(1, 1), b3 + hstep, voffB); PG8_STAGE_A(PG8_SA(1, 0), a3, 0, last);
            PG8_WAIT_V(8); PG8_WAIT_L(0); PG8_BAR; PG8_MMA(1, 0, At, B0); PG8_MMA(1, 1, At, B1); PG8_BAR; PG8_SCHED;
            } else {
            PG8_LDB(B0, 0, 0); PG8_SCHED; PG8_LDA(At, 0, 0); PG8_STAGE(PG8_SA(1, 1), a1 + hstep, voffA);
            PG8_WAIT_L(8); PG8_BAR; PG8_WAIT_L(0); PG8_MMA(0, 0, At, B0); PG8_BAR; PG8_SCHED;
            PG8_LDB(B1, 0, 1); PG8_STAGE(PG8_SB(0, 0), b2, voffB);
            PG8_BAR; PG8_WAIT_L(0); PG8_MMA(0, 1, At, B1); PG8_BAR;
            PG8_LDA(At, 0, 1); PG8_STAGE(PG8_SA(0, 0), a2, voffA);
            PG8_BAR; PG8_WAIT_L(0); PG8_MMA(1, 0, At, B0); PG8_BAR; PG8_SCHED;
            PG8_STAGE(PG8_SB(0, 1), b2 + hstep, voffB);
            PG8_WAIT_V(6); PG8_BAR; PG8_MMA(1, 1, At, B1); PG8_BAR;
            PG8_LDB(B0, 1, 0); PG8_SCHED; PG8_LDA(At, 1, 0); PG8_STAGE(PG8_SA(0, 1), a2 + hstep, voffA);
            PG8_WAIT_L(8); PG8_BAR; PG8_WAIT_L(0); PG8_MMA(0, 0, At, B0); PG8_BAR; PG8_SCHED;
            PG8_LDB(B1, 1, 1); PG8_STAGE(PG8_SB(1, 0), b3, voffB);
            PG8_BAR; PG8_WAIT_L(0); PG8_MMA(0, 1, At, B1); PG8_BAR;
            PG8_LDA(At, 1, 1); PG8_STAGE(PG8_SA(1, 0), a3, voffA);
            PG8_BAR; PG8_WAIT_L(0); PG8_MMA(1, 0, At, B0); PG8_BAR; PG8_SCHED;
            PG8_STAGE(PG8_SB(1, 1), b3 + hstep, voffB);
            PG8_WAIT_V(6); PG8_BAR; PG8_MMA(1, 1, At, B1); PG8_BAR;
            }
        }
        if constexpr (ALIGN_EPI) { if (wr == 0) PG8_BAR; }
        if constexpr (!Epi::AFTER_DRAIN) { E(acc, cur, wr, wc, fr, fq); S.done(cur); }
        if (!has_next) break;
#pragma unroll
        for (int a = 0; a < 2; ++a)
#pragma unroll
            for (int b = 0; b < 2; ++b)
#pragma unroll
                for (int m = 0; m < 4; ++m)
#pragma unroll
                    for (int n = 0; n < 2; ++n) acc[a][b][m][n] = (f32x4){0.f, 0.f, 0.f, 0.f};
        cur = nxt; cA = nA; cB = nB; ++ui;
        if constexpr (GATHER) { _Pragma("unroll") for (int hh_ = 0; hh_ < 2; ++hh_) _Pragma("unroll") for (int i_ = 0; i_ < 2; ++i_) voffAc[hh_][i_] = voffAn[hh_][i_]; }
        if constexpr (ALIGN_EPI) { if (wr == 1) PG8_BAR; }
    }
    PG8_WAIT_V(0);
    if constexpr (!ALIGN_EPI) { if (wr == 0) PG8_BAR; }
    PG8_BAR;
    if constexpr (Epi::AFTER_DRAIN) { E.fused(acc, cur, wr, wc, fr, fq, lds, wid, lane); S.done(cur); }
#undef PG8_SA
#undef PG8_SB
#undef PG8_STAGE
#undef PG8_STAGE_A
#undef PG8_GVOFF
#undef PG8_LDA
#undef PG8_LDB
#undef PG8_MMA
#undef PG8_WAIT_V
#undef PG8_WAIT_L
#undef PG8_BAR
#undef PG8_SCHED
}
template <bool UP>
__device__ __forceinline__ void gemm_quarter(PG8_LAS unsigned char* lds, const Gemm g, const Unit u, int ah, int bh, bf16_t* O, int ldc, const float* gate, int tid_in) {
    int tid_l = tid_in; asm volatile("" : "+v"(tid_l));
    const int tid = tid_l, wid = __builtin_amdgcn_readfirstlane(tid >> 6), lane = tid & 63, wr = wid >> 2, wc = wid & 3, fr = lane & 15, fq = lane >> 4;
    const int K = g.K, nt = K / BK;
    unsigned offA[2], offB[2];
#pragma unroll
    for (int i = 0; i < 2; ++i) { int R, C; stage_rc(tid * 16 + i * 8192, R, C);
        const int ra = u.pm * BM + ah * HALF + R; const unsigned arow = UP ? (unsigned)g.rowmap[ra] : (unsigned)ra;
        const int rb = UP ? (u.pn * BM + ((R >> 4) & 1) * HALF + bh * 64 + (R >> 5) * 16 + (R & 15)) : (u.pn * BM + bh * HALF + R);
        offA[i] = (arow * (unsigned)K + (unsigned)C) * 2u; offB[i] = ((unsigned)rb * (unsigned)K + (unsigned)C) * 2u; }
    const char* Ab = (const char*)g.A; const char* Bb = (const char*)g.Bt + (g.pe ? (size_t)g.pe[u.pm] * g.bstride : (size_t)0);
    const unsigned ldsw = (unsigned)wid * 1024u;
    const int aoff = lds_byte(wr * 64 + fr, fq * 8), boff = lds_byte(wc * 32 + fr, fq * 8);
#define PQ_STAGE(kt, slot) do { const unsigned so_ = (unsigned)(slot) * (unsigned)(2 * HTB); const size_t ko_ = (size_t)(kt) * (size_t)(BK * 2); _Pragma("unroll") for (int i_ = 0; i_ < 2; ++i_) { \
        __builtin_amdgcn_global_load_lds((const unsigned*)(Ab + offA[i_] + ko_), (PG8_LAS unsigned*)(lds + so_ + ldsw + i_ * 8192), 16, 0, 0); \
        __builtin_amdgcn_global_load_lds((const unsigned*)(Bb + offB[i_] + ko_), (PG8_LAS unsigned*)(lds + so_ + HTB + ldsw + i_ * 8192), 16, 0, 0); } } while (0)
    f32x4 acc[4][2];
#pragma unroll
    for (int m = 0; m < 4; ++m)
#pragma unroll
        for (int n = 0; n < 2; ++n) acc[m][n] = (f32x4){0.f, 0.f, 0.f, 0.f};
    float gwv[4] = {0.f, 0.f, 0.f, 0.f};
    if constexpr (UP) {
#pragma unroll
        for (int m = 0; m < 4; ++m) gwv[m] = gate[u.pm * BM + ah * HALF + wr * 64 + fr + m * 16]; }
    PQ_STAGE(0, 0); PQ_STAGE(1, 1); PQ_STAGE(2, 2);
    bf16x8 At[2][4][2], Bq[2][2][2];
#define PQ_READ(set, slot) do { _Pragma("unroll") for (int n = 0; n < 2; ++n) _Pragma("unroll") for (int k = 0; k < 2; ++k) Bq[set][n][k] = *(const PG8_LAS bf16x8*)(lds + (slot) * (2 * HTB) + HTB + boff + n * 2048 + k * 1024); \
        _Pragma("unroll") for (int m = 0; m < 4; ++m) _Pragma("unroll") for (int k = 0; k < 2; ++k) At[set][m][k] = *(const PG8_LAS bf16x8*)(lds + (slot) * (2 * HTB) + aoff + m * 2048 + k * 1024); } while (0)
    asm volatile("s_waitcnt vmcnt(8)" ::: "memory"); __builtin_amdgcn_s_barrier(); __builtin_amdgcn_sched_barrier(0);
    PQ_READ(0, 0); __builtin_amdgcn_sched_barrier(0);
    for (int t4 = 0; t4 < nt; t4 += 4) {
#pragma unroll
        for (int s = 0; s < 4; ++s) { const int t = t4 + s;
            asm volatile("s_waitcnt vmcnt(4)" ::: "memory"); asm volatile("s_waitcnt lgkmcnt(0)" ::: "memory"); __builtin_amdgcn_s_barrier(); __builtin_amdgcn_sched_barrier(0);
            { const int tn = (t + 3 < nt) ? t + 3 : nt - 1; PQ_STAGE(tn, (s + 3) & 3); }
            PQ_READ((s + 1) & 1, (s + 1) & 3);
            __builtin_amdgcn_sched_barrier(0);
#pragma unroll
            for (int k = 0; k < 2; ++k)
#pragma unroll
                for (int m = 0; m < 4; ++m)
#pragma unroll
                    for (int n = 0; n < 2; ++n) acc[m][n] = __builtin_amdgcn_mfma_f32_16x16x32_bf16(Bq[s & 1][n][k], At[s & 1][m][k], acc[m][n], 0, 0, 0);
            __builtin_amdgcn_sched_barrier(0);
        }
    }
#undef PQ_READ
#undef PQ_STAGE
    const int row0 = u.pm * BM + ah * HALF + wr * 64 + fr;
    if constexpr (UP) {
        const int col0 = u.pn * HALF + bh * 64 + wc * 16 + 4 * fq;
#pragma unroll
        for (int m = 0; m < 4; ++m) { const int row = row0 + m * 16; const float gw = gwv[m]; float o[4];
#pragma unroll
            for (int j = 0; j < 4; ++j) { const float a1 = acc[m][0][j]; o[j] = a1 * sigmoidf_fast(a1) * acc[m][1][j] * gw; }
            uint2 w; w.x = cvt_pk_bf16(o[0], o[1]); w.y = cvt_pk_bf16(o[2], o[3]); *(uint2*)(O + (size_t)row * ldc + col0) = w; }
    } else {
        const int col0 = u.pn * BM + bh * HALF + wc * 32 + 4 * fq;
#pragma unroll
        for (int m = 0; m < 4; ++m)
#pragma unroll
            for (int n = 0; n < 2; ++n) { uint2 w; w.x = cvt_pk_bf16(acc[m][n][0], acc[m][n][1]); w.y = cvt_pk_bf16(acc[m][n][2], acc[m][n][3]);
                *(uint2*)(O + (size_t)(row0 + m * 16) * ldc + col0 + n * 16) = w; }
    }
    asm volatile("s_waitcnt vmcnt(0)" ::: "memory"); asm volatile("s_waitcnt lgkmcnt(0)" ::: "memory"); __builtin_amdgcn_s_barrier();
}
template <bool UP>
__device__ __forceinline__ void gemm_tail(PG8_LAS unsigned char* lds, const Gemm g, const StaticOrder& S, int full, int U, bf16_t* O, int ldc, const float* gate, int tid_in) {
    const int r = U - full, c = S.c;
    for (int i = 0; i * 64 < r; ++i) { const int idx = 64 * i + (c & 7) * 8 + ((c >> 5) & 7), q = (c >> 3) & 3;
        if (idx < r) { Unit u; S.at(full + idx, u); gemm_quarter<UP>(lds, g, u, q >> 1, q & 1, O, ldc, gate, tid_in); } }
}
}
namespace att {
using bf16 = unsigned short;
using bf16x8 = __attribute__((ext_vector_type(8))) short;
using s16x4  = __attribute__((ext_vector_type(4))) short;
using f32x16 = __attribute__((ext_vector_type(16))) float;
using u32x4  = __attribute__((ext_vector_type(4))) unsigned;
constexpr int NW = 8, QBLK = 32, KVBLK = 64;
#define SBAR() __builtin_amdgcn_sched_barrier(0)
__device__ __forceinline__ int crow(int r, int hi) { return (r & 3) + 8 * (r >> 2) + 4 * hi; }
__device__ __forceinline__ unsigned cvtpk(float lo, float hi) { unsigned r; asm volatile("v_cvt_pk_bf16_f32 %0, %1, %2" : "=v"(r) : "v"(lo), "v"(hi)); return r; }
template <int DH> struct Cfg {
  static constexpr int ROWB = DH * 2, SHM_T = KVBLK * DH * 2, ND0 = DH / 16, NOB = DH / 32, CPR = DH / 8, RPP = 512 / CPR, NPASS = 64 / RPP;
  static constexpr float SCALE = (DH == 128) ? 0.088388347648318440f : 0.125f;
  static constexpr int SHM = 8 * SHM_T;
  static constexpr float CEXP = (DH == 128) ? 1.0f : SCALE * 1.4426950408889634f, THRV = (DH == 128) ? 8.f * 1.4426950408889634f : 8.f / SCALE;
};
template <int DH> __device__ __forceinline__ int kswz(int row, int colB) { return row * Cfg<DH>::ROWB + (colB ^ ((row & 7) << 4)); }

template <int DH>
__device__ __forceinline__ void partialSM(f32x16& p0, f32x16& p1, float& m_reg, float& mn, float& alpha) {
  constexpr float C = Cfg<DH>::CEXP;
  float pmax = p0[0];
#pragma unroll
  for (int r = 1; r < 16; ++r) pmax = fmaxf(pmax, p0[r]);
#pragma unroll
  for (int r = 0; r < 16; ++r) pmax = fmaxf(pmax, p1[r]);
  { auto rr = __builtin_amdgcn_permlane32_swap(__float_as_uint(pmax), __float_as_uint(pmax), false, false);
    pmax = fmaxf(__uint_as_float(rr[0]), __uint_as_float(rr[1])); }
  if (__builtin_expect(__all(pmax - m_reg <= Cfg<DH>::THRV), 1)) { mn = m_reg; alpha = 1.f; }
  else { mn = fmaxf(m_reg, pmax); alpha = __builtin_amdgcn_exp2f((m_reg - mn) * C); m_reg = mn; }
  float mnC = -mn * C;
#pragma unroll
  for (int r = 0; r < 16; ++r) p0[r] = fmaf(p0[r], C, mnC);
#pragma unroll
  for (int r = 0; r < 16; ++r) p1[r] = fmaf(p1[r], C, mnC);
#pragma unroll
  for (int r = 0; r < 16; ++r) p0[r] = __builtin_amdgcn_exp2f(p0[r]);
}
__device__ __forceinline__ void partialSM_nomax(f32x16& p0) {
#pragma unroll
  for (int r = 0; r < 16; ++r) p0[r] = __builtin_amdgcn_exp2f(p0[r]);
}
__device__ __forceinline__ void finishSM(f32x16& p0, f32x16& p1, float alpha, float& l_reg, bf16x8& pa0, bf16x8& pa1, bf16x8& pa2, bf16x8& pa3) {
#pragma unroll
  for (int r = 0; r < 16; ++r) p1[r] = __builtin_amdgcn_exp2f(p1[r]);
  float ps = 0;
#pragma unroll
  for (int r = 0; r < 16; ++r) ps += p0[r];
#pragma unroll
  for (int r = 0; r < 16; ++r) ps += p1[r];
  { auto rr = __builtin_amdgcn_permlane32_swap(__float_as_uint(ps), __float_as_uint(ps), false, false);
    ps = __uint_as_float(rr[0]) + __uint_as_float(rr[1]); }
  l_reg = l_reg * alpha + ps;
#define PK4(P, BASE, OUT) do { unsigned a0 = cvtpk(P[BASE + 0], P[BASE + 1]), a1 = cvtpk(P[BASE + 2], P[BASE + 3]);   \
    unsigned b0 = cvtpk(P[BASE + 4], P[BASE + 5]), b1 = cvtpk(P[BASE + 6], P[BASE + 7]);                              \
    auto r0 = __builtin_amdgcn_permlane32_swap(a0, b0, false, false); auto r1 = __builtin_amdgcn_permlane32_swap(a1, b1, false, false); \
    u32x4 w = {r0[0], r1[0], r0[1], r1[1]}; OUT = *reinterpret_cast<bf16x8*>(&w); } while (0)
  PK4(p0, 0, pa0); PK4(p0, 8, pa1); PK4(p1, 0, pa2); PK4(p1, 8, pa3);
#undef PK4
}
template <int DH>
__device__ __forceinline__ void qkt(f32x16& p0, f32x16& p1, const char* Ks, const bf16x8* qr, int r32, int hi) {
  p0 = f32x16{}; p1 = f32x16{};
#pragma unroll
  for (int d0 = 0; d0 < Cfg<DH>::ND0; ++d0) { int cb = (d0 * 16 + hi * 8) * 2;
    bf16x8 b0 = *reinterpret_cast<const bf16x8*>(Ks + kswz<DH>(r32, cb));
    bf16x8 b1 = *reinterpret_cast<const bf16x8*>(Ks + kswz<DH>(32 + r32, cb));
    p0 = __builtin_amdgcn_mfma_f32_32x32x16_bf16(b0, qr[d0], p0, 0, 0, 0);
    p1 = __builtin_amdgcn_mfma_f32_32x32x16_bf16(b1, qr[d0], p1, 0, 0, 0); }
}
template <int DH> __device__ __forceinline__ int v_st(int k, int c) { const int kk = (k & ~0xC) | ((k & 4) << 1) | ((k & 8) >> 1); return ((kk >> 3) * (DH / 32) + (c >> 5)) * 512 + ((kk & 7) * 32 + (c & 31)) * 2; }
__device__ __forceinline__ int v_rd_base(int lane) { return ((lane & 3) << 3) | (((lane >> 2) & 3) << 6) | (((lane >> 4) & 1) << 5) | (((lane >> 5) & 1) << 8); }
template <int DH> constexpr int v_rd_off(int d0, int ks, int half) { return d0 * 512 + ks * (DH / 32) * 1024 + half * (DH / 32) * 512; }
template <int OFF> __device__ __forceinline__ s16x4 tr_read(int vb) {
  s16x4 r; asm volatile("ds_read_b64_tr_b16 %0, %1 offset:%2" : "=&v"(r) : "v"(vb), "i"(OFF) : "memory"); return r;
}
struct VFrag { s16x4 l0, h0, l1, h1, l2, h2, l3, h3; };
template <int DH, int D0> __device__ __forceinline__ void v_issue(VFrag& f, int vb) {
  f.l0 = tr_read<v_rd_off<DH>(D0, 0, 0)>(vb); f.h0 = tr_read<v_rd_off<DH>(D0, 0, 1)>(vb); f.l1 = tr_read<v_rd_off<DH>(D0, 1, 0)>(vb); f.h1 = tr_read<v_rd_off<DH>(D0, 1, 1)>(vb);
  f.l2 = tr_read<v_rd_off<DH>(D0, 2, 0)>(vb); f.h2 = tr_read<v_rd_off<DH>(D0, 2, 1)>(vb); f.l3 = tr_read<v_rd_off<DH>(D0, 3, 0)>(vb); f.h3 = tr_read<v_rd_off<DH>(D0, 3, 1)>(vb);
}
__device__ __forceinline__ void v_mma(f32x16& od, const VFrag& f, bf16x8 pa0, bf16x8 pa1, bf16x8 pa2, bf16x8 pa3) {
#define PK(L, H) (bf16x8){L[0], L[1], L[2], L[3], H[0], H[1], H[2], H[3]}
  od = __builtin_amdgcn_mfma_f32_32x32x16_bf16(pa0, PK(f.l0, f.h0), od, 0, 0, 0);
  od = __builtin_amdgcn_mfma_f32_32x32x16_bf16(pa1, PK(f.l1, f.h1), od, 0, 0, 0);
  od = __builtin_amdgcn_mfma_f32_32x32x16_bf16(pa2, PK(f.l2, f.h2), od, 0, 0, 0);
  od = __builtin_amdgcn_mfma_f32_32x32x16_bf16(pa3, PK(f.l3, f.h3), od, 0, 0, 0);
#undef PK
}
template <int DH> __device__ __forceinline__ void pv_d0(f32x16* o, int vb, bf16x8 pa0, bf16x8 pa1, bf16x8 pa2, bf16x8 pa3) {
  VFrag fa, fb;
  v_issue<DH, 0>(fa, vb);
  v_issue<DH, 1>(fb, vb); asm volatile("s_waitcnt lgkmcnt(8)" ::: "memory"); SBAR(); v_mma(o[0], fa, pa0, pa1, pa2, pa3); SBAR();
  if constexpr (DH == 128) {
    v_issue<DH, 2>(fa, vb); asm volatile("s_waitcnt lgkmcnt(8)" ::: "memory"); SBAR(); v_mma(o[1], fb, pa0, pa1, pa2, pa3); SBAR();
    v_issue<DH, 3>(fb, vb); asm volatile("s_waitcnt lgkmcnt(8)" ::: "memory"); SBAR(); v_mma(o[2], fa, pa0, pa1, pa2, pa3); SBAR();
    asm volatile("s_waitcnt lgkmcnt(0)" ::: "memory"); SBAR(); v_mma(o[3], fb, pa0, pa1, pa2, pa3);
  } else {
    asm volatile("s_waitcnt lgkmcnt(0)" ::: "memory"); SBAR(); v_mma(o[1], fb, pa0, pa1, pa2, pa3);
  }
}
__device__ __forceinline__ float exp2_s(float x) { float r; asm("v_exp_f32 %0, %1" : "=v"(r) : "v"(x)); return r; }
__device__ __forceinline__ float add_s(float a, float b) { float r; asm("v_add_f32 %0, %1, %2" : "=v"(r) : "v"(a), "v"(b)); return r; }
struct VFrag;
template <int D0, int HALF> __device__ __forceinline__ void v_issue_half(VFrag& f, int vb);
__device__ __forceinline__ void qk_fin_nm(f32x16& x0, f32x16& x1, const char* Ks, const bf16x8* qr, int r32, int hi,
                                          const f32x16& y0, f32x16& y1, float sy0, float& l_reg, bf16x8& pa0, bf16x8& pa1, bf16x8& pa2, bf16x8& pa3, VFrag& vf, int vb);
template <int D0, int HALF> __device__ __forceinline__ void v_issue_half(VFrag& f, int vb) {
  if constexpr (HALF == 0) { f.l0 = tr_read<v_rd_off<128>(D0, 0, 0)>(vb); f.h0 = tr_read<v_rd_off<128>(D0, 0, 1)>(vb); f.l1 = tr_read<v_rd_off<128>(D0, 1, 0)>(vb); f.h1 = tr_read<v_rd_off<128>(D0, 1, 1)>(vb); }
  else                     { f.l2 = tr_read<v_rd_off<128>(D0, 2, 0)>(vb); f.h2 = tr_read<v_rd_off<128>(D0, 2, 1)>(vb); f.l3 = tr_read<v_rd_off<128>(D0, 3, 0)>(vb); f.h3 = tr_read<v_rd_off<128>(D0, 3, 1)>(vb); }
}
__device__ __forceinline__ void qk_fin_nm(f32x16& x0, f32x16& x1, const char* Ks, const bf16x8* qr, int r32, int hi,
                                          const f32x16& y0, f32x16& y1, float sy0, float& l_reg, bf16x8& pa0, bf16x8& pa1, bf16x8& pa2, bf16x8& pa3, VFrag& vf, int vb) {
  x0 = f32x16{}; x1 = f32x16{};
  bf16x8 ka[8], kc[8];
#define LDK(d) do { const int cb_ = ((d) * 16 + hi * 8) * 2; ka[d] = *reinterpret_cast<const bf16x8*>(Ks + kswz<128>(r32, cb_)); kc[d] = *reinterpret_cast<const bf16x8*>(Ks + kswz<128>(32 + r32, cb_)); } while (0)
  LDK(0); LDK(1);
  float s1 = 0.f; unsigned c0[8], c1[8]; unsigned w[4][4];
#define SWP(i, a, b) do { auto r0_ = __builtin_amdgcn_permlane32_swap(c##a[b], c##a[(b) + 2], false, false); auto r1_ = __builtin_amdgcn_permlane32_swap(c##a[(b) + 1], c##a[(b) + 3], false, false); \
    w[i][0] = r0_[0]; w[i][1] = r1_[0]; w[i][2] = r0_[1]; w[i][3] = r1_[1]; } while (0)
#pragma unroll
  for (int t = 0; t < 16; ++t) { const int d0 = t >> 1;
    if ((t & 1) == 0 && d0 + 2 < 8) LDK(d0 + 2);
    if (t & 1) x1 = __builtin_amdgcn_mfma_f32_32x32x16_bf16(kc[d0], qr[d0], x1, 0, 0, 0); else x0 = __builtin_amdgcn_mfma_f32_32x32x16_bf16(ka[d0], qr[d0], x0, 0, 0, 0);
    y1[t] = exp2_s(y1[t]);
    if (t > 0) s1 = add_s(s1, y1[t - 1]);
    if (t < 8) c0[t] = cvtpk(y0[2 * t], y0[2 * t + 1]); else c1[t - 8] = cvtpk(y1[2 * (t - 8)], y1[2 * (t - 8) + 1]);
    if (t == 4) SWP(0, 0, 0);
    if (t == 8) SWP(1, 0, 4);
    if (t == 12) SWP(2, 1, 0);
    if (t == 14) v_issue_half<0, 0>(vf, vb);
    if (t == 15) v_issue_half<0, 1>(vf, vb);
    SBAR(); }
  asm volatile("" : "+v"(x0), "+v"(x1));
  s1 = add_s(s1, y1[15]); SWP(3, 1, 4);
  float ps = sy0 + s1; { auto rr = __builtin_amdgcn_permlane32_swap(__float_as_uint(ps), __float_as_uint(ps), false, false); ps = __uint_as_float(rr[0]) + __uint_as_float(rr[1]); }
  l_reg += ps;
  { u32x4 q0 = {w[0][0], w[0][1], w[0][2], w[0][3]}, q1 = {w[1][0], w[1][1], w[1][2], w[1][3]}, q2 = {w[2][0], w[2][1], w[2][2], w[2][3]}, q3 = {w[3][0], w[3][1], w[3][2], w[3][3]};
    pa0 = __builtin_bit_cast(bf16x8, q0); pa1 = __builtin_bit_cast(bf16x8, q1); pa2 = __builtin_bit_cast(bf16x8, q2); pa3 = __builtin_bit_cast(bf16x8, q3); }
#undef LDK
#undef SWP
}
#define PVPK(L, H) (bf16x8){L[0], L[1], L[2], L[3], H[0], H[1], H[2], H[3]}
struct StageW { char* d0; char* d1; bf16x8 v0, v1; };
template <int G> __device__ __forceinline__ void pv_block_nm(f32x16& od, VFrag& cur, VFrag& nxt, int vb, bf16x8 pa0, bf16x8 pa1, bf16x8 pa2, bf16x8 pa3, f32x16& x0, float& sx, const StageW* sw = nullptr) {
  od = __builtin_amdgcn_mfma_f32_32x32x16_bf16(pa0, PVPK(cur.l0, cur.h0), od, 0, 0, 0); x0[4 * G + 0] = exp2_s(x0[4 * G + 0]); if constexpr (G > 0) sx = add_s(sx, x0[4 * G - 1]); if constexpr (G < 3) v_issue_half<G + 1, 0>(nxt, vb); SBAR();
  od = __builtin_amdgcn_mfma_f32_32x32x16_bf16(pa1, PVPK(cur.l1, cur.h1), od, 0, 0, 0); x0[4 * G + 1] = exp2_s(x0[4 * G + 1]); sx = add_s(sx, x0[4 * G + 0]); if constexpr (G < 3) v_issue_half<G + 1, 1>(nxt, vb); SBAR();
  od = __builtin_amdgcn_mfma_f32_32x32x16_bf16(pa2, PVPK(cur.l2, cur.h2), od, 0, 0, 0); x0[4 * G + 2] = exp2_s(x0[4 * G + 2]); sx = add_s(sx, x0[4 * G + 1]); if (sw) *(bf16x8*)sw->d0 = sw->v0; SBAR();
  od = __builtin_amdgcn_mfma_f32_32x32x16_bf16(pa3, PVPK(cur.l3, cur.h3), od, 0, 0, 0); x0[4 * G + 3] = exp2_s(x0[4 * G + 3]); sx = add_s(sx, x0[4 * G + 2]); if (sw) *(bf16x8*)sw->d1 = sw->v1; SBAR();
  if constexpr (G < 3) { asm volatile("s_waitcnt lgkmcnt(0)" ::: "memory"); SBAR(); }
}
__device__ __forceinline__ void pv_psm_nm(f32x16* o, int vb, bf16x8 pa0, bf16x8 pa1, bf16x8 pa2, bf16x8 pa3, f32x16& x0, float& sx, VFrag& fa, const StageW* swv = nullptr, const StageW* swk = nullptr) {
  VFrag fb;
  asm volatile("s_waitcnt lgkmcnt(0)" ::: "memory"); SBAR();
  sx = 0.f;
  pv_block_nm<0>(o[0], fa, fb, vb, pa0, pa1, pa2, pa3, x0, sx);
  pv_block_nm<1>(o[1], fb, fa, vb, pa0, pa1, pa2, pa3, x0, sx);
  pv_block_nm<2>(o[2], fa, fb, vb, pa0, pa1, pa2, pa3, x0, sx, swv);
  pv_block_nm<3>(o[3], fb, fa, vb, pa0, pa1, pa2, pa3, x0, sx, swk);
  sx = add_s(sx, x0[15]);
  asm volatile("" : "+v"(o[0]), "+v"(o[1]), "+v"(o[2]), "+v"(o[3]));
}
#undef PVPK
struct StageRegs { bf16x8 vs[2], ks[2]; };
__device__ __forceinline__ int vtswz(int d, int colB) { return d * 128 + (colB ^ (((d >> 1) & 7) << 4)); }
__device__ __forceinline__ void attn_step_nm(f32x16& x0, f32x16& x1, const f32x16& y0, f32x16& y1, float sy0, float& sx0, float& l_reg, f32x16* o, const bf16x8* qr, int r32, int hi,
                                             const char* Kcur, const char* Vtprev,
                                             StageRegs& ld, const bf16* vsrc, long vstride, const bf16* ksrc, long kstride, const StageRegs& wr, char* vdst0, char* vdst1, char* kdst0, char* kdst1) {
  x0 = f32x16{}; x1 = f32x16{};
  bf16x8 ka[8], kc[8];
#define LDK(d, base) do { const int cb_ = ((d) * 16 + hi * 8) * 2; ka[d] = *reinterpret_cast<const bf16x8*>((base) + kswz<128>(r32, cb_)); kc[d] = *reinterpret_cast<const bf16x8*>((base) + kswz<128>(32 + r32, cb_)); } while (0)
#define LDV(G, ks) (*reinterpret_cast<const bf16x8*>(Vtprev + vtswz(32 * (G) + r32, (2 * (ks) + hi) * 16)))
  float s1 = 0.f; unsigned c0[8], c1[8];
  bf16x8 va[4], vb[4];
#pragma unroll
  for (int t = 0; t < 16; ++t) { const int d0 = t >> 1;
    if (t == 0) { LDK(0, Kcur); LDK(1, Kcur); }
    if ((t & 1) == 0 && d0 + 2 < 8) LDK(d0 + 2, Kcur);
    if (t & 1) x1 = __builtin_amdgcn_mfma_f32_32x32x16_bf16(kc[d0], qr[d0], x1, 0, 0, 0); else x0 = __builtin_amdgcn_mfma_f32_32x32x16_bf16(ka[d0], qr[d0], x0, 0, 0, 0);
    y1[t] = exp2_s(y1[t]);
    if (t > 0) s1 = add_s(s1, y1[t - 1]);
    if (t < 8) c0[t] = cvtpk(y0[2 * t], y0[2 * t + 1]); else if (t < 15) c1[t - 8] = cvtpk(y1[2 * (t - 8)], y1[2 * (t - 8) + 1]);
    if (t == 1) { ld.vs[0] = *reinterpret_cast<const bf16x8*>(vsrc); ld.vs[1] = *reinterpret_cast<const bf16x8*>(vsrc + vstride); ld.ks[0] = *reinterpret_cast<const bf16x8*>(ksrc); ld.ks[1] = *reinterpret_cast<const bf16x8*>(ksrc + kstride); }
    if (t == 14) { va[0] = LDV(0, 0); va[1] = LDV(0, 1); }
    if (t == 15) { va[2] = LDV(0, 2); va[3] = LDV(0, 3); }
    SBAR(); }
  asm volatile("" : "+v"(x0), "+v"(x1));
  bf16x8 pf0, pf1, pf2, pf3;
  { u32x4 q0 = {c0[0], c0[1], c0[2], c0[3]}, q1 = {c0[4], c0[5], c0[6], c0[7]}, q2 = {c1[0], c1[1], c1[2], c1[3]};
    pf0 = __builtin_bit_cast(bf16x8, q0); pf1 = __builtin_bit_cast(bf16x8, q1); pf2 = __builtin_bit_cast(bf16x8, q2); }
#define PVM(G, i, F, PF) o[G] = __builtin_amdgcn_mfma_f32_32x32x16_bf16(F[i], PF, o[G], 0, 0, 0); x0[4 * G + i] = exp2_s(x0[4 * G + i])
  float sx = 0.f;
  PVM(0, 0, va, pf0); c1[7] = cvtpk(y1[14], y1[15]); s1 = add_s(s1, y1[15]); vb[0] = LDV(1, 0); vb[1] = LDV(1, 1); SBAR();
  PVM(0, 1, va, pf1); sx = add_s(sx, x0[0]); vb[2] = LDV(1, 2); vb[3] = LDV(1, 3); SBAR();
  { u32x4 q3 = {c1[4], c1[5], c1[6], c1[7]}; pf3 = __builtin_bit_cast(bf16x8, q3); }
  PVM(0, 2, va, pf2); sx = add_s(sx, x0[1]); float ps = sy0 + s1; SBAR();
  PVM(0, 3, va, pf3); sx = add_s(sx, x0[2]); { auto rr = __builtin_amdgcn_permlane32_swap(__float_as_uint(ps), __float_as_uint(ps), false, false); ps = __uint_as_float(rr[0]) + __uint_as_float(rr[1]); } l_reg += ps; SBAR();
  PVM(1, 0, vb, pf0); sx = add_s(sx, x0[3]); va[0] = LDV(2, 0); va[1] = LDV(2, 1); SBAR();
  PVM(1, 1, vb, pf1); sx = add_s(sx, x0[4]); va[2] = LDV(2, 2); va[3] = LDV(2, 3); SBAR();
  PVM(1, 2, vb, pf2); sx = add_s(sx, x0[5]); SBAR();
  PVM(1, 3, vb, pf3); sx = add_s(sx, x0[6]); SBAR();
  PVM(2, 0, va, pf0); sx = add_s(sx, x0[7]); vb[0] = LDV(3, 0); vb[1] = LDV(3, 1); SBAR();
  PVM(2, 1, va, pf1); sx = add_s(sx, x0[8]); vb[2] = LDV(3, 2); vb[3] = LDV(3, 3); SBAR();
  PVM(2, 2, va, pf2); sx = add_s(sx, x0[9]); *(bf16x8*)vdst0 = wr.vs[0]; SBAR();
  PVM(2, 3, va, pf3); sx = add_s(sx, x0[10]); *(bf16x8*)vdst1 = wr.vs[1]; SBAR();
  PVM(3, 0, vb, pf0); sx = add_s(sx, x0[11]); SBAR();
  PVM(3, 1, vb, pf1); sx = add_s(sx, x0[12]); SBAR();
  PVM(3, 2, vb, pf2); sx = add_s(sx, x0[13]); *(bf16x8*)kdst0 = wr.ks[0]; SBAR();
  PVM(3, 3, vb, pf3); sx = add_s(sx, x0[14]); *(bf16x8*)kdst1 = wr.ks[1]; SBAR();
  sx0 = add_s(sx, x0[15]);
  asm volatile("" : "+v"(o[0]), "+v"(o[1]), "+v"(o[2]), "+v"(o[3]));
#undef LDK
#undef LDV
#undef PVM
}
__device__ __forceinline__ void finish_t(const f32x16& y0, f32x16& y1, float& l_reg, bf16x8 (&pf)[4]) {
#pragma unroll
  for (int r = 0; r < 16; ++r) y1[r] = __builtin_amdgcn_exp2f(y1[r]);
  float ps = 0.f;
#pragma unroll
  for (int r = 0; r < 16; ++r) ps += y0[r] + y1[r];
  { auto rr = __builtin_amdgcn_permlane32_swap(__float_as_uint(ps), __float_as_uint(ps), false, false); ps = __uint_as_float(rr[0]) + __uint_as_float(rr[1]); }
  l_reg += ps;
#pragma unroll
  for (int s_ = 0; s_ < 2; ++s_) { u32x4 a = {cvtpk(y0[8 * s_], y0[8 * s_ + 1]), cvtpk(y0[8 * s_ + 2], y0[8 * s_ + 3]), cvtpk(y0[8 * s_ + 4], y0[8 * s_ + 5]), cvtpk(y0[8 * s_ + 6], y0[8 * s_ + 7])};
    u32x4 c = {cvtpk(y1[8 * s_], y1[8 * s_ + 1]), cvtpk(y1[8 * s_ + 2], y1[8 * s_ + 3]), cvtpk(y1[8 * s_ + 4], y1[8 * s_ + 5]), cvtpk(y1[8 * s_ + 6], y1[8 * s_ + 7])};
    pf[s_] = __builtin_bit_cast(bf16x8, a); pf[2 + s_] = __builtin_bit_cast(bf16x8, c); }
}
__device__ __forceinline__ void pv_t(f32x16* o, const char* Vt, const bf16x8 (&pf)[4], int r32, int hi) {
#pragma unroll
  for (int G = 0; G < 4; ++G)
#pragma unroll
    for (int ks = 0; ks < 4; ++ks) o[G] = __builtin_amdgcn_mfma_f32_32x32x16_bf16(*reinterpret_cast<const bf16x8*>(Vt + vtswz(32 * G + r32, (2 * ks + hi) * 16)), pf[ks], o[G], 0, 0, 0);
}
__device__ __forceinline__ void swa_mask(f32x16& p0, f32x16& p1, int kt0, int qt, int hi, int seq) {
#pragma unroll
  for (int r = 0; r < 16; ++r) { const int k0 = kt0 + crow(r, hi), k1 = k0 + 32; const int d0 = k0 - qt, d1 = k1 - qt;
    const bool v0 = (k0 >= 0) && (k0 < seq) && (d0 <= 128) && (d0 >= -128); const bool v1 = (k1 >= 0) && (k1 < seq) && (d1 <= 128) && (d1 >= -128);
    p0[r] = v0 ? p0[r] : -1e30f; p1[r] = v1 ? p1[r] : -1e30f; }
}
template <int DH, bool SWA, int ldq, int ldk, int ldo, int seq, bool NOMAX = false, bool QPRO = false>
__device__ __forceinline__ void attn_unit(const bf16* __restrict__ Qb, const bf16* __restrict__ Kb, const bf16* __restrict__ Vb,
                                          bf16* __restrict__ Ob, int NT, int t0, bool has_sink, float sink, char* lds,
                                          int tid_in, const float* __restrict__ qgain = nullptr, const float* __restrict__ cosT = nullptr, const float* __restrict__ sinT = nullptr, int tq0 = -1,
                                          const bf16* __restrict__ Vtb = nullptr, int vtpitch = 0) {
  using C = Cfg<DH>;
  constexpr int SHM_T = C::SHM_T, NPASS = C::NPASS, RPP = C::RPP, CPR = C::CPR;
  int tid_l = HW_TID(tid_in  ); asm volatile("" : "+v"(tid_l));
  const int tid = tid_l, wid = tid_in  , lane = tid & 63, r32 = lane & 31, hi = lane >> 5;
  constexpr int NS = (NOMAX && DH == 128 && !SWA) ? 4 : 2;
  char* V_lds = lds; char* K_lds = lds + NS * SHM_T;
  float* ws = (float*)(lds + (NS == 4 ? 131072 + 1024 : 2 * NS * SHM_T)) + wid * 64; float* li_l = ws; float* al_l = ws + 32;
  float m_reg = -1e30f, l_reg = 0; f32x16 o[C::NOB] = {}; bf16x8 qr[C::ND0];
  const bf16* Qw = Qb + (long)(wid * QBLK + r32) * ldq + hi * 8;
#pragma unroll
  for (int d0 = 0; d0 < C::ND0; ++d0) qr[d0] = *reinterpret_cast<const bf16x8*>(Qw + d0 * 16);
  if constexpr (QPRO) {
    static_assert(DH == 128, "QPRO is written for head dim 128");
    float qf[8][8]; float ss = 0.f;
#pragma unroll
    for (int d0 = 0; d0 < 8; ++d0) { const u32x4 w = __builtin_bit_cast(u32x4, qr[d0]);
#pragma unroll
      for (int e = 0; e < 4; ++e) { qf[d0][2 * e] = __uint_as_float(w[e] << 16); qf[d0][2 * e + 1] = __uint_as_float(w[e] & 0xffff0000u); }
#pragma unroll
      for (int e = 0; e < 8; ++e) ss = fmaf(qf[d0][e], qf[d0][e], ss); }
    { auto rr = __builtin_amdgcn_permlane32_swap(__float_as_uint(ss), __float_as_uint(ss), false, false); ss = __uint_as_float(rr[0]) + __uint_as_float(rr[1]); }
    const float rs = 0.12751741437781343f / sqrtf(ss * (1.0f / 128.f) + 1e-6f);
#pragma unroll
    for (int d0 = 0; d0 < 8; ++d0) { const float* gp = qgain + d0 * 16 + hi * 8;
#pragma unroll
      for (int e = 0; e < 8; ++e) qf[d0][e] *= rs * gp[e]; }
    if (tq0 >= 0) { const int t = tq0 + wid * QBLK + r32;
#pragma unroll
      for (int ax = 0; ax < 2; ++ax) { const int pos = ax ? (t & 63) : (t >> 6);
#pragma unroll
        for (int dd = 0; dd < 2; ++dd) { const int d0 = ax * 4 + dd; const float* cp = cosT + pos * 32 + dd * 16 + hi * 8; const float* sp = sinT + pos * 32 + dd * 16 + hi * 8;
#pragma unroll
          for (int e = 0; e < 8; ++e) { const float c = cp[e], sn = sp[e], x1 = qf[d0][e], x2 = qf[d0 + 2][e]; qf[d0][e] = x1 * c - x2 * sn; qf[d0 + 2][e] = x2 * c + x1 * sn; } } } }
#pragma unroll
    for (int d0 = 0; d0 < 8; ++d0) { u32x4 w = {cvtpk(qf[d0][0], qf[d0][1]), cvtpk(qf[d0][2], qf[d0][3]), cvtpk(qf[d0][4], qf[d0][5]), cvtpk(qf[d0][6], qf[d0][7])}; qr[d0] = __builtin_bit_cast(bf16x8, w); }
  }
  const int sr = tid / CPR, sc = (tid % CPR) * 8;
  int vst[NPASS], kst[NPASS];
#pragma unroll
  for (int i = 0; i < NPASS; ++i) { vst[i] = v_st<DH>(sr + i * RPP, sc); kst[i] = kswz<DH>(sr + i * RPP, sc * 2); }
  const int vb0 = (int)(uintptr_t)V_lds + v_rd_base(lane);
  struct { bf16x8 vs[NPASS], ks[NPASS]; } sr_[2];
  const int qt = t0 + wid * QBLK + r32;
  auto trow = [&](int j) -> long { if constexpr (!SWA) return (long)j * KVBLK; else { if (j < 4) return (long)j * KVBLK; int t = t0 - 128 + (j - 4) * KVBLK; t = t < 0 ? 0 : (t > seq - KVBLK ? seq - KVBLK : t); return 256L + t; } };
#define SLOAD(i, j_) do { const long k0_ = trow(j_); _Pragma("unroll") for (int q_ = 0; q_ < NPASS; ++q_) { \
    sr_[i].vs[q_] = *reinterpret_cast<const bf16x8*>(&Vb[(k0_ + sr + q_ * RPP) * ldk + sc]); sr_[i].ks[q_] = *reinterpret_cast<const bf16x8*>(&Kb[(k0_ + sr + q_ * RPP) * ldk + sc]); } } while (0)
#define SWRITE(b, i) do { _Pragma("unroll") for (int q_ = 0; q_ < NPASS; ++q_) { *(bf16x8*)(V_lds + (b) * SHM_T + vst[q_]) = sr_[i].vs[q_]; *(bf16x8*)(K_lds + (b) * SHM_T + kst[q_]) = sr_[i].ks[q_]; } } while (0)
#define SWAIT() do { if constexpr (NPASS == 2) asm volatile("s_waitcnt vmcnt(4)" ::: "memory"); else asm volatile("s_waitcnt vmcnt(2)" ::: "memory"); } while (0)
#define RESC(a) do { if constexpr (!NOMAX) if (__any((a) < 1.f)) { if (hi == 0) al_l[r32] = (a); asm volatile("s_waitcnt lgkmcnt(0)" ::: "memory"); \
    _Pragma("unroll") for (int d = 0; d < C::NOB; ++d) _Pragma("unroll") for (int r = 0; r < 16; ++r) o[d][r] *= al_l[crow(r, hi)]; } } while (0)
#define PSM(P0, P1, MN, AL) do { if constexpr (NOMAX) { partialSM_nomax(P0); AL = 1.f; } else partialSM<DH>(P0, P1, m_reg, MN, AL); } while (0)
#define MASK(P0, P1, j_) do { if constexpr (SWA) { if ((j_) >= 4) { const int kt_ = t0 - 128 + ((j_) - 4) * KVBLK, q0_ = t0 + wid * QBLK; \
    if (!(kt_ >= q0_ + 31 - 128 && kt_ + 63 <= q0_ + 128)) swa_mask(P0, P1, kt_, qt, hi, seq); } } } while (0)
  f32x16 pA0, pA1, pB0, pB1; float mnA, mnB, alA, alB; bf16x8 pa0, pa1, pa2, pa3;
  constexpr int SE = 0, SO = 1;
  auto act = [&](int j) -> bool { if constexpr (!SWA) return true; else { if (j < 4) return true; const int m = j - 4, kt_ = t0 - 128 + m * KVBLK; return m >= (wid >> 1) && m <= (wid >> 1) + 4 && kt_ >= 0 && kt_ < seq; } };
  if constexpr (NOMAX && DH == 128 && !SWA) {
    const int sr2 = tid >> 3, c2 = tid & 7;
    int vtst[2];
#pragma unroll
    for (int q_ = 0; q_ < 2; ++q_) vtst[q_] = vtswz(sr2 + 64 * q_, 16 * c2);
#define SWRITEO(boff, R) do { _Pragma("unroll") for (int q_ = 0; q_ < NPASS; ++q_) { *(bf16x8*)(V_lds + (boff) + vtst[q_]) = R.vs[q_]; *(bf16x8*)(K_lds + (boff) + kst[q_]) = R.ks[q_]; } } while (0)
#define GLOAD(R, j_) do { const long jt_ = (j_) < NT ? (j_) : NT - 1; const long k0_ = trow(jt_); _Pragma("unroll") for (int q_ = 0; q_ < NPASS; ++q_) { \
      R.vs[q_] = *reinterpret_cast<const bf16x8*>(&Vtb[(long)(sr2 + 64 * q_) * vtpitch + 64 * jt_ + 8 * c2]); R.ks[q_] = *reinterpret_cast<const bf16x8*>(&Kb[(k0_ + sr + q_ * RPP) * ldk + sc]); } } while (0)
#define ROT4() do { const int t_ = bq; bq = bc; bc = bn; bn = bw; bw = t_; } while (0)
    static_assert(NPASS == 2, "hand-placed path: two 16-byte pieces per matrix per thread");
    StageRegs rA, rB;
    { StageRegs rC; GLOAD(rA, 0); GLOAD(rB, 1); GLOAD(rC, 2);
      __syncthreads();
      asm volatile("s_waitcnt vmcnt(8)" ::: "memory"); SWRITEO(0, rA); asm volatile("s_waitcnt vmcnt(4)" ::: "memory"); SWRITEO(SHM_T, rB);
      GLOAD(rB, 3); asm volatile("s_waitcnt vmcnt(4)" ::: "memory"); SWRITEO(2 * SHM_T, rC); __syncthreads(); }
    qkt<DH>(pA0, pA1, K_lds, qr, r32, hi); partialSM_nomax(pA0);
    float sA = 0.f, sB = 0.f;
#pragma unroll
    for (int r = 0; r < 16; ++r) sA += pA0[r];
    int bq = 0, bc = SHM_T, bn = 2 * SHM_T, bw = 3 * SHM_T;
    const long kstride = (long)RPP * ldk, vstride = 64L * vtpitch;
    for (int j = 1; j + 1 < NT; j += 2) {
      { const long jt_ = j + 3 < NT ? j + 3 : NT - 1; const long k0_ = trow(jt_);
        attn_step_nm(pB0, pB1, pA0, pA1, sA, sB, l_reg, o, qr, r32, hi, K_lds + bc, V_lds + bq,
                     rA, &Vtb[(long)sr2 * vtpitch + 64 * jt_ + 8 * c2], vstride, &Kb[(k0_ + sr) * ldk + sc], kstride, rB, V_lds + bw + vtst[0], V_lds + bw + vtst[1], K_lds + bw + kst[0], K_lds + bw + kst[1]); }
      __syncthreads(); ROT4();
      { const long jt_ = j + 4 < NT ? j + 4 : NT - 1; const long k0_ = trow(jt_);
        attn_step_nm(pA0, pA1, pB0, pB1, sB, sA, l_reg, o, qr, r32, hi, K_lds + bc, V_lds + bq,
                     rB, &Vtb[(long)sr2 * vtpitch + 64 * jt_ + 8 * c2], vstride, &Kb[(k0_ + sr) * ldk + sc], kstride, rA, V_lds + bw + vtst[0], V_lds + bw + vtst[1], K_lds + bw + kst[0], K_lds + bw + kst[1]); }
      __syncthreads(); ROT4();
    }
    { bf16x8 pf[4];
      SBAR(); qkt<DH>(pB0, pB1, K_lds + bc, qr, r32, hi);
      finish_t(pA0, pA1, l_reg, pf); SBAR();
      pv_t(o, V_lds + bq, pf, r32, hi); partialSM_nomax(pB0);
      finish_t(pB0, pB1, l_reg, pf); SBAR();
      pv_t(o, V_lds + bc, pf, r32, hi); }
    { const float rl = __builtin_amdgcn_rcpf(l_reg); bf16* Orow = Ob + (long)(wid * QBLK + r32) * ldo + 4 * hi;
#pragma unroll
      for (int G = 0; G < 4; ++G)
#pragma unroll
        for (int qd = 0; qd < 4; ++qd) { u32x4 dummy; (void)dummy; unsigned w0 = cvtpk(o[G][4 * qd] * rl, o[G][4 * qd + 1] * rl), w1 = cvtpk(o[G][4 * qd + 2] * rl, o[G][4 * qd + 3] * rl);
          typedef unsigned u32x2_t __attribute__((ext_vector_type(2))); u32x2_t w = {w0, w1}; *(u32x2_t*)(Orow + 32 * G + 8 * qd) = w; } }
    return;
#undef GLOAD
#undef ROT4
#undef SWRITEO
  } else {
  SLOAD(SE, 0); SLOAD(SO, 1); SWAIT(); SWRITE(0, SE); __syncthreads();
  qkt<DH>(pA0, pA1, K_lds, qr, r32, hi); PSM(pA0, pA1, mnA, alA);
  if (2 < NT) { SLOAD(SE, 2); SWAIT(); } else asm volatile("s_waitcnt vmcnt(0)" ::: "memory");
  SWRITE(1, SO); __syncthreads();
  bool aA = true, aB = true;
  for (int j = 1; j + 1 < NT; j += 2) {
    aB = act(j);
    SBAR(); if (aB) { qkt<DH>(pB0, pB1, K_lds + SHM_T, qr, r32, hi); MASK(pB0, pB1, j); }
    if (aA) finishSM(pA0, pA1, alA, l_reg, pa0, pa1, pa2, pa3); SBAR();
    SLOAD(SO, j + 2); SBAR();
    if (aA) pv_d0<DH>(o, vb0, pa0, pa1, pa2, pa3);
    if (aB) PSM(pB0, pB1, mnB, alB); else alB = 1.f;
    __syncthreads(); SWAIT(); SWRITE(0, SE);
    RESC(alB); __syncthreads();
    aA = act(j + 1);
    SBAR(); if (aA) { qkt<DH>(pA0, pA1, K_lds, qr, r32, hi); MASK(pA0, pA1, j + 1); }
    if (aB) finishSM(pB0, pB1, alB, l_reg, pa0, pa1, pa2, pa3); SBAR();
    if (j + 3 < NT) SLOAD(SE, j + 3); SBAR();
    if (aB) pv_d0<DH>(o, vb0 + SHM_T, pa0, pa1, pa2, pa3);
    if (aA) PSM(pA0, pA1, mnA, alA); else alA = 1.f;
    __syncthreads(); SWAIT(); SWRITE(1, SO);
    RESC(alA); __syncthreads();
  }
  aB = act(NT - 1);
  SBAR(); if (aB) { qkt<DH>(pB0, pB1, K_lds + SHM_T, qr, r32, hi); MASK(pB0, pB1, NT - 1); }
  if (aA) finishSM(pA0, pA1, alA, l_reg, pa0, pa1, pa2, pa3); SBAR();
  if (aA) pv_d0<DH>(o, vb0, pa0, pa1, pa2, pa3);
  if (aB) PSM(pB0, pB1, mnB, alB); else alB = 1.f;
  __syncthreads(); RESC(alB);
  if (aB) { finishSM(pB0, pB1, alB, l_reg, pa0, pa1, pa2, pa3); SBAR();
            pv_d0<DH>(o, vb0 + SHM_T, pa0, pa1, pa2, pa3); }
  }
  if (has_sink) l_reg += __builtin_amdgcn_exp2f(sink * 1.4426950408889634f - m_reg * (C::SCALE * 1.4426950408889634f));
  if (hi == 0) li_l[r32] = l_reg; asm volatile("s_waitcnt lgkmcnt(0)" ::: "memory");
  float rli[16];
#pragma unroll
  for (int r = 0; r < 16; ++r) rli[r] = __builtin_amdgcn_rcpf(li_l[crow(r, hi)]);
  bf16* Ow = Ob + (long)(wid * QBLK) * ldo;
#pragma unroll
  for (int r = 0; r < 16; ++r) { const int orow = crow(r, hi);
#pragma unroll
    for (int d0 = 0; d0 < C::NOB; ++d0) { const float v = o[d0][r] * rli[r]; Ow[(long)orow * ldo + d0 * 32 + r32] = (bf16)(cvtpk(v, v) & 0xffffu); } }
#undef SLOAD
#undef SWRITE
#undef SWAIT
#undef RESC
#undef MASK
#undef PSM
}
#undef SBAR
__device__ __forceinline__ void sbar_() { __builtin_amdgcn_sched_barrier(0); }
}
constexpr int DM = 1024, NBATCH = 2, SEQ = 16384, NCTX = 256, RPB = SEQ + NCTX, NR = NBATCH * RPB, NCHUNK = RPB / 128;
constexpr int NEXP = 16, DEXP = 512;
constexpr int MAXPAN = NR * 2 / 256 + NEXP, MAXSLOT = MAXPAN * 256;
constexpr float ALPHA = 1.6817928305074290f, LN_EPS = 1e-6f, RMS_EPS = 1e-6f;
constexpr int QKV_B = 1280, QKV_C = 1536;
constexpr int NGRID = 256, NWAVES = 8, NTHREADS = 512;
constexpr int NPHASE = 2 + 9 * 4;
#ifndef MK_MULTI
#define MK_MULTI 0
#endif
constexpr size_t MiB = 1u << 20;
constexpr size_t WS_CTL = 0, CTL_ZERO_BYTES = 1 * MiB;
constexpr size_t WS_MOD = 1 * MiB;
constexpr size_t WS_ROPE = WS_MOD + 512 * 1024;
constexpr size_t WS_LAM = 2 * MiB;
constexpr size_t WS_DFR = WS_LAM + 256 * 1024;
constexpr size_t WS_FTAB = WS_LAM + 512 * 1024;
constexpr size_t WS_BBF = 3 * MiB;
constexpr size_t WS_CMF = 4 * MiB;
constexpr size_t WS_ROUTE = 6 * MiB;
constexpr size_t WS_CNTB = 8 * MiB;
constexpr size_t WS_PANE = WS_CNTB + 64 * 1024;
constexpr size_t WS_GSLOT = 9 * MiB;
constexpr size_t WS_ROWMAP = 9 * MiB + 512 * 1024;
constexpr size_t WS_E = 12 * MiB;
constexpr size_t WS_HIN = 29 * MiB;
constexpr size_t WS_WGLU = 46 * MiB;
constexpr size_t WS_WQKVB = 54 * MiB, WS_WOB = 57 * MiB, WS_WQKVC = 59 * MiB, WS_WOC = 62 * MiB;
constexpr size_t WS_WUP = 64 * MiB;
constexpr size_t WS_WDN = 96 * MiB;
constexpr size_t WS_H = 112 * MiB;
constexpr size_t WS_T = 177 * MiB;
constexpr size_t WS_QKV = WS_T, WS_O = WS_T + 98 * MiB, WS_Y = WS_T + 163 * MiB;
constexpr size_t WS_HS = WS_T, WS_ACT = WS_T + 138 * MiB;
constexpr size_t WS_X = WS_T + 228 * MiB;
constexpr size_t WS_S5T = WS_X + 65 * MiB;
constexpr size_t WS_KT = WS_S5T + 10 * MiB;
constexpr size_t WS_VT = WS_KT + 1 * MiB;
constexpr size_t WS_END = WS_VT + 17 * MiB;
static_assert((size_t)(NR + 128) * QKV_C * 2 <= 98 * MiB && (size_t)NR * DM * 2 <= 65 * MiB && (size_t)MAXSLOT * DM * 2 <= 138 * MiB && (size_t)MAXSLOT * DEXP * 2 <= 69 * MiB, "temp map");
static_assert((size_t)2 * NCHUNK * 2 * 64 * 128 * 4 <= 17 * MiB, "E map");
constexpr int CW_BAR = 4096;
constexpr int RING_BYTES = 131072, LDSCTL_OFF = RING_BYTES, MISC_OFF = LDSCTL_OFF + 320, LDS_BYTES = 147456;

typedef unsigned short bf16;
typedef unsigned v4u __attribute__((ext_vector_type(4)));
typedef unsigned v2u __attribute__((ext_vector_type(2)));
typedef float f32x4 __attribute__((ext_vector_type(4)));
typedef float f32x16 __attribute__((ext_vector_type(16)));
typedef short bf16x8 __attribute__((ext_vector_type(8)));
typedef short s16x4 __attribute__((ext_vector_type(4)));
#define LAS __attribute__((address_space(3)))
#define LDS_WAIT() asm volatile("s_waitcnt lgkmcnt(0)" ::: "memory")
__device__ __forceinline__ unsigned pk2(float lo, float hi) { unsigned r; asm("v_cvt_pk_bf16_f32 %0, %1, %2" : "=v"(r) : "v"(lo), "v"(hi)); return r; }
__device__ __forceinline__ unsigned f2bf(float f) { return pk2(f, f) & 0xffffu; }
__device__ __forceinline__ float bf2f(unsigned short h) { return __builtin_bit_cast(float, (unsigned)h << 16); }
__device__ __forceinline__ float bflo(unsigned w) { return __builtin_bit_cast(float, w << 16); }
__device__ __forceinline__ float bfhi(unsigned w) { return __builtin_bit_cast(float, w & 0xffff0000u); }
__device__ __forceinline__ float wave_sum(float v) {
#define DPPF(x, ctrl, rmask) __builtin_bit_cast(float, __builtin_amdgcn_update_dpp(0, __builtin_bit_cast(int, (x)), (ctrl), (rmask), 0xf, false))
    v += DPPF(v, 0xb1, 0xf);
    v += DPPF(v, 0x4e, 0xf);
    v += DPPF(v, 0x124, 0xf);
    v += DPPF(v, 0x128, 0xf);
    v += DPPF(v, 0x142, 0xa);
    v += DPPF(v, 0x143, 0xc);
#undef DPPF
    return __builtin_bit_cast(float, __builtin_amdgcn_readlane(__builtin_bit_cast(int, v), 63));
}
#define XB_TMO      128
#define XB_XCNT(j)  (256  + 64 * (j))
#define XB_XSUB(j)  (1280 + 64 * (j))
#define XB_XGEN(j)  (2304 + 64 * (j))
#define XB_TOP      3328
#define XB_TOPGEN   3392
#define XCD_BAR_WORDS 3456
#define XB_SPIN_CAP (1u << 20)

__device__ __forceinline__ unsigned xb_ld(unsigned* p)              { return __hip_atomic_load(p, __ATOMIC_RELAXED, __HIP_MEMORY_SCOPE_AGENT); }
__device__ __forceinline__ unsigned xb_add(unsigned* p, unsigned v) { return __hip_atomic_fetch_add(p, v, __ATOMIC_RELAXED, __HIP_MEMORY_SCOPE_AGENT); }
__device__ __forceinline__ unsigned xb_xcc_id() { return (unsigned)__builtin_amdgcn_s_getreg((3 << 11) | 20) & 0xFu; }
#define XB_SPIN(cond, bar) do { unsigned _sp = 0; while (cond) { __builtin_amdgcn_s_sleep(1); \
    if ((++_sp & 255u) == 0u) { if (xb_ld(&(bar)[XB_TMO])) break; if (_sp > XB_SPIN_CAP) { atomicAdd(&(bar)[XB_TMO], 1u); break; } } } } while (0)

struct XcdBarrier {
    unsigned* bar; unsigned x;
    volatile LAS unsigned* st;
};

__device__ __forceinline__ XcdBarrier xcd_barrier_post(unsigned* bar, volatile LAS unsigned* st) {
    XcdBarrier b; b.bar = bar; b.x = xb_xcc_id(); b.st = st;
    if (threadIdx.x == 0) (void)xb_add(&bar[XB_XCNT(b.x)], 1u);
    return b;
}
__device__ __forceinline__ void xcd_barrier_complete(unsigned* bar, unsigned x, unsigned& nloc, unsigned& nx) {
    const unsigned G = gridDim.x * gridDim.y * gridDim.z;
    unsigned sum, cnt, mine, sp = 0u;
    for (;;) {
        sum = 0u; cnt = 0u; mine = 0u;
#pragma unroll
        for (unsigned j = 0; j < 16; ++j) { const unsigned c = xb_ld(&bar[XB_XCNT(j)]); sum += c; cnt += (c > 0u) ? 1u : 0u; mine = (j == x) ? c : mine; }
        if (sum == G) break;
        __builtin_amdgcn_s_sleep(1);
        if ((++sp & 255u) == 0u) { if (xb_ld(&bar[XB_TMO])) break; if (sp > XB_SPIN_CAP) { atomicAdd(&bar[XB_TMO], 1u); break; } }
    }
    nloc = mine > 0u ? mine : 1u; nx = cnt > 0u ? cnt : 1u;
}

__device__ __forceinline__ void xcd_barrier(const XcdBarrier& b, bool leader  ) {
    asm volatile("s_waitcnt vmcnt(0)" ::: "memory");
    __syncthreads();
    if (leader) {
        unsigned* bar = b.bar;
        __builtin_amdgcn_s_waitcnt(0);
        unsigned nloc = b.st[0], nx = b.st[1];
        if (nloc == 0u) { xcd_barrier_complete(bar, b.x, nloc, nx); b.st[0] = nloc; b.st[1] = nx; }
        const unsigned old = xb_add(&bar[XB_XSUB(b.x)], 1u);
        const unsigned gen = old / nloc;
        if (old + 1u == (gen + 1u) * nloc) {
            __builtin_amdgcn_fence(__ATOMIC_RELEASE, "agent");
            asm volatile("s_waitcnt vmcnt(0)" ::: "memory");
            const unsigned og = xb_add(&bar[XB_TOP], 1u);
            const unsigned tg = og / nx;
            if (og + 1u == (tg + 1u) * nx) xb_add(&bar[XB_TOPGEN], 1u);
            else XB_SPIN(xb_ld(&bar[XB_TOPGEN]) == tg, bar);
            __builtin_amdgcn_fence(__ATOMIC_ACQUIRE, "agent");
            xb_add(&bar[XB_XGEN(b.x)], 1u);
            asm volatile("s_waitcnt vmcnt(0)" ::: "memory");
        } else {
            XB_SPIN(xb_ld(&bar[XB_TOPGEN]) == gen, bar);
            __builtin_amdgcn_fence(__ATOMIC_ACQUIRE, "agent");
            asm volatile("s_waitcnt vmcnt(0)" ::: "memory");
        }
    }
    __syncthreads();
}
struct Params { const float* in[30]; float* out; unsigned char* ws; int ph_lo, ph_hi; };
enum { I_X = 0, I_C, I_CTX, I_CCTX, I_MODW, I_MODB, I_LNG, I_LNB, I_RW, I_RB, I_W1, I_W3, I_W2, I_ARE, I_AIM, I_LOGDT, I_BRE, I_BIM, I_CRE, I_CIM, I_S5D, I_WGATE, I_WVAL,
       I_SWAQKV, I_SWAO, I_SINK, I_GQAQKV, I_GQAO, I_QNORM, I_KNORM };

__device__ __forceinline__ float fold16(float (&p)[16], int lane) {
#define DPPF(x, ctrl) __builtin_bit_cast(float, __builtin_amdgcn_update_dpp(0, __builtin_bit_cast(int, (x)), (ctrl), 0xf, 0xf, false))
#pragma unroll
    for (int i = 0; i < 8; ++i) { auto r = __builtin_amdgcn_permlane32_swap(__float_as_uint(p[i]), __float_as_uint(p[i + 8]), false, false); p[i] = __uint_as_float(r[0]) + __uint_as_float(r[1]); }
#pragma unroll
    for (int i = 0; i < 4; ++i) { auto r = __builtin_amdgcn_permlane16_swap(__float_as_uint(p[i]), __float_as_uint(p[i + 4]), false, false); p[i] = __uint_as_float(r[0]) + __uint_as_float(r[1]); }
    { const bool up = (lane & 8) != 0;
#pragma unroll
      for (int i = 0; i < 2; ++i) { const float mine = up ? p[i + 2] : p[i], other = up ? p[i] : p[i + 2]; p[i] = mine + DPPF(other, 0x128); } }
    { const bool up = (lane & 4) != 0; const float mine = up ? p[1] : p[0], other = up ? p[0] : p[1]; p[0] = mine + __shfl_xor(other, 4); }
    float t = p[0]; t += DPPF(t, 0x4e); t += DPPF(t, 0xb1);
#undef DPPF
    return t;
}
__device__ __forceinline__ void ti_load(const float* __restrict__ W, int N, int k0, int n0, int lane, f32x4 (&wv)[8]) {
#pragma unroll
    for (int i = 0; i < 8; ++i) wv[i] = __builtin_nontemporal_load((const f32x4*)&W[(size_t)(k0 + 8 * i + (lane >> 3)) * N + n0 + 4 * (lane & 7)]);
}
__device__ __forceinline__ void ti_store(const f32x4 (&wv)[8], bf16* __restrict__ WT, int Kout, int out_row0, LAS float* scr, int k0, int lane) {
#pragma unroll
    for (int i = 0; i < 8; ++i) { LAS float* d = scr + (8 * i + (lane >> 3)) * 33 + 4 * (lane & 7); d[0] = wv[i][0]; d[1] = wv[i][1]; d[2] = wv[i][2]; d[3] = wv[i][3]; }
    LDS_WAIT(); asm volatile("" ::: "memory");
    const int c = lane & 7;
#pragma unroll
    for (int j = 0; j < 4; ++j) { const int n = (lane >> 3) + 8 * j; const LAS float* s = scr + (8 * c) * 33 + n;
        v4u o; o.x = pk2(s[0 * 33], s[1 * 33]); o.y = pk2(s[2 * 33], s[3 * 33]); o.z = pk2(s[4 * 33], s[5 * 33]); o.w = pk2(s[6 * 33], s[7 * 33]);
        *(v4u*)(WT + (size_t)(out_row0 + n) * Kout + k0 + 8 * c) = o; }
    LDS_WAIT(); asm volatile("" ::: "memory");
}
__device__ __forceinline__ void transpose_item(const float* __restrict__ W, int N, bf16* __restrict__ WT, int Kout, int out_row0, LAS float* scr, int k0, int n0, int lane) {
    f32x4 wv[8]; ti_load(W, N, k0, n0, lane, wv); ti_store(wv, WT, Kout, out_row0, scr, k0, lane);
}
__device__ __forceinline__ int glu_row(int n0, int second) { return (n0 >> 7) * 256 + (n0 & 127) + second * 128; }

__device__ __forceinline__ void moe_convert(const Params& P, int layer, LAS unsigned char* lds, int gw, int ngw, int wave, int lane) {
    LAS float* scr = (LAS float*)(lds + wave * 16384);
    bf16* Wup = (bf16*)(P.ws + WS_WUP); bf16* Wdn = (bf16*)(P.ws + WS_WDN);
#define CV_DEC(it_, W_, WT_, N_, Kout_, row0_, k0_, n0_) const float* W_; bf16* WT_; int N_, Kout_, row0_, k0_, n0_; { const int e_ = (it_) / 768, rr_ = (it_) % 768, which_ = rr_ >> 8, q_ = rr_ & 255; const size_t eo_ = (size_t)(layer * NEXP + e_); \
        if (which_ == 2) { const int kb_ = q_ >> 5, nb_ = q_ & 31; W_ = P.in[I_W2] + eo_ * DEXP * DM; N_ = DM; WT_ = Wdn + (size_t)e_ * DM * DEXP; Kout_ = DEXP; row0_ = 32 * nb_; k0_ = 64 * kb_; n0_ = 32 * nb_; } \
        else { const int kb_ = q_ >> 4, nb_ = q_ & 15; W_ = (which_ ? P.in[I_W3] : P.in[I_W1]) + eo_ * DM * DEXP; N_ = DEXP; WT_ = Wup + (size_t)e_ * DM * DM; Kout_ = DM; row0_ = glu_row(32 * nb_, which_); k0_ = 64 * kb_; n0_ = 32 * nb_; } }
    constexpr int TOT = NEXP * 768;
    f32x4 wa[8], wb[8];
    int it = gw;
    if (it < TOT) { CV_DEC(it, W0, T0, N0, K0, R0, k0, n0); (void)T0; (void)K0; (void)R0; ti_load(W0, N0, k0, n0, lane, wa); }
    while (it < TOT) {
        { const int itn = it + ngw; if (itn < TOT) { CV_DEC(itn, W1, T1, N1, K1, R1, k1, n1); (void)T1; (void)K1; (void)R1; ti_load(W1, N1, k1, n1, lane, wb); }
          CV_DEC(it, W0, T0, N0, K0, R0, k0, n0); (void)W0; (void)N0; (void)n0; ti_store(wa, T0, K0, R0, scr, k0, lane); it = itn; }
        if (it >= TOT) break;
        { const int itn = it + ngw; if (itn < TOT) { CV_DEC(itn, W1, T1, N1, K1, R1, k1, n1); (void)T1; (void)K1; (void)R1; ti_load(W1, N1, k1, n1, lane, wa); }
          CV_DEC(it, W0, T0, N0, K0, R0, k0, n0); (void)W0; (void)N0; (void)n0; ti_store(wb, T0, K0, R0, scr, k0, lane); it = itn; }
    }
#undef CV_DEC
}

__device__ __forceinline__ void sincos_red(float x, float& s, float& c) {
    const float n = rintf(x * 0.15915494309189535f);
    float r = fmaf(-n, 6.28125f, x); r = fmaf(-n, 1.9353071795864769e-3f, r);
    s = sinf(r); c = cosf(r);
}

__device__ __forceinline__ void phase_prologue(const Params& P, LAS unsigned char* lds, int tid, int wave, int lane) {
    const int G = gridDim.x, gw = blockIdx.x * NWAVES + wave, ngw = G * NWAVES;
    unsigned char* ws = P.ws;
    {
        LAS float* scr = (LAS float*)(lds + wave * 16384);
        constexpr int I_SQ = 16 * 32, I_QB = 16 * 40, I_QC = 16 * 48;
        constexpr int NIT = 4 * I_SQ + I_QB + I_SQ + I_QC + I_SQ;
        bf16* Wglu = (bf16*)(ws + WS_WGLU);
        for (int it = gw; it < NIT; it += ngw) {
            int r = it;
            if (r < 4 * I_SQ) { const int m = r / I_SQ, q = r % I_SQ, j = m >> 1, isgate = m & 1, kb = q >> 5, nb = q & 31;
                transpose_item(P.in[isgate ? I_WGATE : I_WVAL] + (size_t)j * DM * DM, DM, Wglu + (size_t)j * 2048 * DM, DM, glu_row(32 * nb, isgate), scr, 64 * kb, 32 * nb, lane); continue; }
            r -= 4 * I_SQ;
            if (r < I_QB) { const int kb = r / 40, nb = r % 40; transpose_item(P.in[I_SWAQKV], QKV_B, (bf16*)(ws + WS_WQKVB), DM, 32 * nb, scr, 64 * kb, 32 * nb, lane); continue; }
            r -= I_QB;
            if (r < I_SQ) { const int kb = r >> 5, nb = r & 31; transpose_item(P.in[I_SWAO], DM, (bf16*)(ws + WS_WOB), DM, 32 * nb, scr, 64 * kb, 32 * nb, lane); continue; }
            r -= I_SQ;
            if (r < I_QC) { const int kb = r / 48, nb = r % 48; transpose_item(P.in[I_GQAQKV], QKV_C, (bf16*)(ws + WS_WQKVC), DM, 32 * nb, scr, 64 * kb, 32 * nb, lane); continue; }
            r -= I_QC;
            { const int kb = r >> 5, nb = r & 31; transpose_item(P.in[I_GQAO], DM, (bf16*)(ws + WS_WOC), DM, 32 * nb, scr, 64 * kb, 32 * nb, lane); }
        }
    }
    moe_convert(P, 0, lds, gw, ngw, wave, lane);
    __syncthreads();
    {
        LAS float* sc = (LAS float*)lds; LAS float* red = (LAS float*)(lds + 16384);
        float* MOD = (float*)(ws + WS_MOD);
        for (int item = blockIdx.x; item < 4 * 96; item += G) {
            const int layer = item / 96, col0 = (item % 96) * 64;
            for (int idx = tid; idx < 3072; idx += NTHREADS) { const int c = idx >> 10, k = idx & 1023; const float v = c < 2 ? P.in[I_C][c * DM + k] : P.in[I_CCTX][k]; sc[idx] = v / (1.0f + expf(-v)); }
            __syncthreads();
            const int colq = tid & 15, kq = tid >> 4;
            float acc[3][4];
#pragma unroll
            for (int c = 0; c < 3; ++c)
#pragma unroll
                for (int j = 0; j < 4; ++j) acc[c][j] = 0.f;
            const float* wb = P.in[I_MODW] + ((size_t)layer * DM + kq * 32) * 6144 + col0 + 4 * colq;
#pragma unroll 16
            for (int kk = 0; kk < 32; ++kk) { const f32x4 w = __builtin_nontemporal_load((const f32x4*)(wb + (size_t)kk * 6144)); const int k = kq * 32 + kk;
                const float s0 = sc[k], s1 = sc[1024 + k], s2 = sc[2048 + k];
#pragma unroll
                for (int j = 0; j < 4; ++j) { acc[0][j] = fmaf(s0, w[j], acc[0][j]); acc[1][j] = fmaf(s1, w[j], acc[1][j]); acc[2][j] = fmaf(s2, w[j], acc[2][j]); } }
#pragma unroll
            for (int c = 0; c < 3; ++c)
#pragma unroll
                for (int j = 0; j < 4; ++j) red[(kq * 3 + c) * 64 + 4 * colq + j] = acc[c][j];
            __syncthreads();
            if (tid < 192) { const int c = tid >> 6, col = tid & 63; float s = 0.f;
                for (int q = 0; q < 32; ++q) s += red[(q * 3 + c) * 64 + col];
                MOD[(size_t)(layer * 3 + c) * 6144 + col0 + col] = s + P.in[I_MODB][(size_t)layer * 6144 + col0 + col]; }
            __syncthreads();
        }
    }
    {
        const int gt = blockIdx.x * NTHREADS + tid, ngt = G * NTHREADS;
        float* rope = (float*)(ws + WS_ROPE);
        for (int idx = gt; idx < 4096 + 8192; idx += ngt) {
            if (idx < 4096) { const int pos = idx >> 4, i = idx & 15; const float inv = exp2f(-(float)i * (13.287712379549449f / 16.f)); float s, c; sincos_red((float)pos * inv, s, c); rope[idx] = c; rope[4096 + idx] = s; }
            else { const int k = idx - 4096, pos = k >> 5, i = k & 31; const float inv = exp2f(-(float)i * (13.287712379549449f / 32.f)); float s, c; sincos_red((float)pos * inv, s, c); rope[8192 + k] = c; rope[16384 + k] = s; }
        }
        float* LAM = (float*)(ws + WS_LAM); float* FT = (float*)(ws + WS_FTAB);
        for (int idx = gt; idx < 256 * 64; idx += ngt) {
            const int combo = idx >> 6, p = idx & 63;
            const float are = P.in[I_ARE][combo * 64 + p], aim = P.in[I_AIM][combo * 64 + p], dt = expf(P.in[I_LOGDT][combo]);
            const float mag = expf(are * dt); float sn, cs; sincos_red(aim * dt, sn, cs);
            const float lre = mag * cs, lim = mag * sn, inv_den = 1.0f / (are * are + aim * aim), nre = lre - 1.0f;
            const float fre = (nre * are + lim * aim) * inv_den, fim = (lim * are - nre * aim) * inv_den;
            LAM[(size_t)(combo * 2 + 0) * 64 + p] = lre; LAM[(size_t)(combo * 2 + 1) * 64 + p] = lim;
            FT[(size_t)(combo * 2 + 0) * 64 + p] = fre; FT[(size_t)(combo * 2 + 1) * 64 + p] = fim;
        }
    }
}

__device__ __forceinline__ void phase_h0(const Params& P, int wave, int lane) {
    const int gw = blockIdx.x * NWAVES + wave, ngw = gridDim.x * NWAVES;
    const float* MOD = (const float*)(P.ws + WS_MOD); bf16* H = (bf16*)(P.ws + WS_H);
    constexpr int NB = 6;
    for (int row0 = gw; row0 < NR; row0 += NB * ngw) {
        f32x4 xv[NB][4];
#pragma unroll
        for (int k = 0; k < NB; ++k) { const int row = row0 + k * ngw < NR ? row0 + k * ngw : row0; const int b = row >= RPB ? 1 : 0, rr = row - b * RPB; const bool isctx = rr < NCTX;
            const float* xs = isctx ? P.in[I_CTX] + (size_t)(b * NCTX + rr) * DM : P.in[I_X] + (size_t)(b * SEQ + rr - NCTX) * DM;
#pragma unroll
            for (int j = 0; j < 4; ++j) xv[k][j] = __builtin_nontemporal_load((const f32x4*)(xs + 4 * lane + 256 * j)); }
#pragma unroll
        for (int k = 0; k < NB; ++k) { const int row = row0 + k * ngw; if (row >= NR) continue; const int b = row >= RPB ? 1 : 0, rr = row - b * RPB; const bool isctx = rr < NCTX;
            const float* mod = MOD + (size_t)(0 * 3 + (isctx ? 2 : b)) * 6144;
#pragma unroll
            for (int j = 0; j < 4; ++j) { const int col = 4 * lane + 256 * j; const f32x4 x = xv[k][j], sh = *(const f32x4*)(mod + col), sc = *(const f32x4*)(mod + 1024 + col);
                v2u o; o.x = pk2(fmaf(x[0], sc[0], x[0]) + sh[0], fmaf(x[1], sc[1], x[1]) + sh[1]); o.y = pk2(fmaf(x[2], sc[2], x[2]) + sh[2], fmaf(x[3], sc[3], x[3]) + sh[3]);
                *(v2u*)(H + (size_t)row * DM + col) = o; } }
    }
}
__device__ __forceinline__ void cpow(float lr, float li, int e, float& or_, float& oi) { float ar = 1.f, ai = 0.f; for (int k = 0; k < e; ++k) { const float t = ar * lr - ai * li; ai = ar * li + ai * lr; ar = t; } or_ = ar; oi = ai; }
__device__ __forceinline__ void phase_s5_tables(const Params& P, int tid) {
    const int gt = blockIdx.x * NTHREADS + tid, ngt = gridDim.x * NTHREADS;
    const float* LAM = (const float*)(P.ws + WS_LAM); const float* FT = (const float*)(P.ws + WS_FTAB); v4u* T = (v4u*)(P.ws + WS_S5T);
    for (int idx = gt; idx < 128 * 72 * 64; idx += ngt) {
        const int l = idx & 63, f = (idx >> 6) % 72, jg = idx / (72 * 64), j = jg >> 6, g = jg & 63, r32 = l & 31, h = l >> 5;
        float v[8];
        if (f < 32) { const int d = f >> 4, r = (f >> 2) & 3, t = f & 3, sp = t >> 1, ri = t & 1, p = sp * 32 + r32, combo = (j * 2 + d) * 64 + g;
            const float lr = LAM[(size_t)(combo * 2) * 64 + p], li = LAM[(size_t)(combo * 2 + 1) * 64 + p], fr = FT[(size_t)(combo * 2) * 64 + p], fi = FT[(size_t)(combo * 2 + 1) * 64 + p];
            float pr, pi; cpow(lr, li, d == 0 ? 3 - r : r, pr, pi); const float wr = pr * fr - pi * fi, wi = pr * fi + pi * fr;
            const float* bre = P.in[I_BRE] + ((size_t)combo * 64 + p) * 16 + 8 * h; const float* bim = P.in[I_BIM] + ((size_t)combo * 64 + p) * 16 + 8 * h;
#pragma unroll
            for (int jj = 0; jj < 8; ++jj) v[jj] = ri == 0 ? wr * bre[jj] - wi * bim[jj] : wr * bim[jj] + wi * bre[jj];
        } else if (f < 64) { const int q = f - 32, d = q >> 4, ks = (q >> 1) & 7, n = q & 1, sp = ks >> 2, ri = (ks >> 1) & 1, s_ = ks & 1, r = 2 * n + (r32 >> 4), c = r32 & 15, combo = (j * 2 + d) * 64 + g;
#pragma unroll
            for (int jj = 0; jj < 8; ++jj) { const int p = sp * 32 + 16 * s_ + 8 * h + jj;
                const float lr = LAM[(size_t)(combo * 2) * 64 + p], li = LAM[(size_t)(combo * 2 + 1) * 64 + p]; float pr, pi; cpow(lr, li, d == 0 ? r + 1 : 4 - r, pr, pi);
                const float cr = P.in[I_CRE][((size_t)combo * 16 + c) * 64 + p], ci = P.in[I_CIM][((size_t)combo * 16 + c) * 64 + p];
                v[jj] = ri == 0 ? cr * pr - ci * pi : -(cr * pi + ci * pr); }
        } else continue;
        v4u o; o.x = pk2(v[0], v[1]); o.y = pk2(v[2], v[3]); o.z = pk2(v[4], v[5]); o.w = pk2(v[6], v[7]);
        T[idx] = o;
    }
    float* KT = (float*)(P.ws + WS_KT);
    for (int idx = gt; idx < 128 * 2 * 256; idx += ngt) {
        const int cp = idx & 15, c = (idx >> 4) & 15, d = (idx >> 8) & 1, jg = idx >> 9, j = jg >> 6, g = jg & 63, combo = (j * 2 + d) * 64 + g;
        const float* lam_r = LAM + (size_t)(combo * 2) * 64; const float* lam_i = lam_r + 64; const float* f_r = FT + (size_t)(combo * 2) * 64; const float* f_i = f_r + 64;
        const float* cre = P.in[I_CRE] + ((size_t)combo * 16 + c) * 64; const float* cim = P.in[I_CIM] + ((size_t)combo * 16 + c) * 64;
        const float* bre = P.in[I_BRE] + (size_t)combo * 64 * 16 + cp; const float* bim = P.in[I_BIM] + (size_t)combo * 64 * 16 + cp;
        float acc0 = 0.f, acc1 = 0.f, acc2 = 0.f, acc3 = 0.f;
#pragma unroll 8
        for (int p = 0; p < 64; ++p) { const float lr = lam_r[p], li = lam_i[p], br = bre[p * 16], bi = bim[p * 16];
            float zr = cre[p] * f_r[p] - cim[p] * f_i[p], zi = cre[p] * f_i[p] + cim[p] * f_r[p], t_;
            acc0 += zr * br - zi * bi; t_ = zr * lr - zi * li; zi = zr * li + zi * lr; zr = t_;
            acc1 += zr * br - zi * bi; t_ = zr * lr - zi * li; zi = zr * li + zi * lr; zr = t_;
            acc2 += zr * br - zi * bi; t_ = zr * lr - zi * li; zi = zr * li + zi * lr; zr = t_;
            acc3 += zr * br - zi * bi; }
        float* kd = KT + ((size_t)jg << 11) + (d << 10) + (c << 4) + cp;
        kd[0] = acc0; kd[256] = acc1; kd[512] = acc2; kd[768] = acc3;
    }
}

#define MFMA32(a, b, c) __builtin_amdgcn_mfma_f32_32x32x16_bf16((a), (b), (c), 0, 0, 0)
template <bool REV, bool WITH_S>
__device__ __forceinline__ void s5_scan_tile(f32x16& xr, f32x16& xi, float lr, float li, float l4r, float l4i, float& cr, float& ci, int h) {
    const bool first = REV ? (h == 1) : (h == 0);
    float er[4], ei[4];
#pragma unroll
    for (int q = 0; q < 4; ++q) {
        float sr = 0.f, si = 0.f;
#pragma unroll
        for (int r = 0; r < 4; ++r) { const int reg = REV ? 15 - (4 * q + r) : 4 * q + r;
            if (r == 0) { sr = xr[reg]; si = xi[reg]; }
            else { const float nr = fmaf(lr, sr, fmaf(-li, si, xr[reg])), ni = fmaf(lr, si, fmaf(li, sr, xi[reg])); sr = nr; si = ni; } }
        er[q] = sr; ei[q] = si;
    }
    float zr = cr, zi = ci, cinr[4], cini[4];
#pragma unroll
    for (int q = 0; q < 4; ++q) {
        const auto sr_ = __builtin_amdgcn_permlane32_swap(__float_as_uint(er[q]), __float_as_uint(er[q]), false, false), si_ = __builtin_amdgcn_permlane32_swap(__float_as_uint(ei[q]), __float_as_uint(ei[q]), false, false);
        const float ar = __uint_as_float(REV ? sr_[1] : sr_[0]), ai = __uint_as_float(REV ? si_[1] : si_[0]), br = __uint_as_float(REV ? sr_[0] : sr_[1]), bi = __uint_as_float(REV ? si_[0] : si_[1]);
        const float mr = fmaf(l4r, zr, fmaf(-l4i, zi, ar)), mi = fmaf(l4r, zi, fmaf(l4i, zr, ai));
        cinr[q] = first ? zr : mr; cini[q] = first ? zi : mi;
        const float z2r = fmaf(l4r, mr, fmaf(-l4i, mi, br)), z2i = fmaf(l4r, mi, fmaf(l4i, mr, bi));
        zr = z2r; zi = z2i;
    }
    cr = zr; ci = zi;
    if constexpr (WITH_S) {
#pragma unroll
        for (int q = 0; q < 4; ++q) { float sr = cinr[q], si = cini[q];
#pragma unroll
            for (int r = 0; r < 4; ++r) { const int reg = REV ? 15 - (4 * q + r) : 4 * q + r;
                const float nr = fmaf(lr, sr, fmaf(-li, si, xr[reg])), ni = fmaf(lr, si, fmaf(li, sr, xi[reg])); sr = nr; si = ni; xr[reg] = sr; xi[reg] = si; } }
    }
}
__device__ __forceinline__ void s5_store_img(LAS unsigned char* img, const f32x16& x, int r32, int h) {
#pragma unroll
    for (int gq = 0; gq < 4; ++gq) { v2u v; v.x = pg8::cvt_pk_bf16(x[4 * gq], x[4 * gq + 1]); v.y = pg8::cvt_pk_bf16(x[4 * gq + 2], x[4 * gq + 3]);
        *(LAS v2u*)(img + r32 * 72 + 8 * (2 * gq + h)) = v; }
}
__device__ __forceinline__ void s5_read_img(unsigned base, int lane, bf16x8& a0, bf16x8& a1) {
    const int i16 = lane & 15, q = i16 >> 2, p = i16 & 3, blk = (lane >> 4) & 1, h = lane >> 5;
    const unsigned ad = base + (8 * h + q) * 72 + 8 * (4 * blk + p);
    s16x4 l0, h0, l1, h1;
    asm volatile("ds_read_b64_tr_b16 %0, %4\n\tds_read_b64_tr_b16 %1, %4 offset:288\n\tds_read_b64_tr_b16 %2, %4 offset:1152\n\tds_read_b64_tr_b16 %3, %4 offset:1440\n\ts_waitcnt lgkmcnt(0)"
                 : "=&v"(l0), "=&v"(h0), "=&v"(l1), "=&v"(h1) : "v"(ad) : "memory");
    a0 = __builtin_shufflevector(l0, h0, 0, 1, 2, 3, 4, 5, 6, 7); a1 = __builtin_shufflevector(l1, h1, 0, 1, 2, 3, 4, 5, 6, 7);
}
__device__ __forceinline__ float gelu_tanh(float x) { const float z = 0.7978845608028654f * fmaf(0.044715f * x, x * x, x); return x * pg8::sigmoidf_fast(2.0f * z); }

template <bool WITH_OUT>
__device__ __forceinline__ void s5_chunk(const Params& P, int j, int b, int c, int g, int lane, LAS unsigned char* img) {
    const int r32 = lane & 31, h = lane >> 5;
    const bf16* H = (const bf16*)(P.ws + WS_H); const int row0 = b * RPB + c * 128;
    const float* LAM = (const float*)(P.ws + WS_LAM); const bf16x8* BBF = (const bf16x8*)(P.ws + WS_BBF); const bf16x8* CMF = (const bf16x8*)(P.ws + WS_CMF);
    bf16x8 ua[4];
#pragma unroll
    for (int tb = 0; tb < 4; ++tb) ua[tb] = *(const bf16x8*)(H + (size_t)(row0 + 32 * tb + r32) * DM + 16 * g + 8 * h);
    f32x16 y[4];
    if constexpr (WITH_OUT) { const bf16x8 df = ((const bf16x8*)(P.ws + WS_DFR))[(size_t)(j * 64 + g) * 64 + lane];
#pragma unroll
        for (int tb = 0; tb < 4; ++tb) { f32x16 z = {}; y[tb] = MFMA32(ua[tb], df, z); } }
    const unsigned imgb = (unsigned)(uintptr_t)img;
#pragma unroll
    for (int dir = 0; dir < 2; ++dir) {
        const int combo = (j * 2 + dir) * 64 + g;
        float lr[2], li[2], l4r[2], l4i[2], cr[2], ci[2];
        const size_t eidx = ((size_t)((b * NCHUNK + c) * 2 + dir) * 64 + g) * 128;
#pragma unroll
        for (int sp = 0; sp < 2; ++sp) { lr[sp] = LAM[(size_t)(combo * 2 + 0) * 64 + sp * 32 + r32]; li[sp] = LAM[(size_t)(combo * 2 + 1) * 64 + sp * 32 + r32];
            const float l2r = lr[sp] * lr[sp] - li[sp] * li[sp], l2i = 2.f * lr[sp] * li[sp]; l4r[sp] = l2r * l2r - l2i * l2i; l4i[sp] = 2.f * l2r * l2i;
            if constexpr (WITH_OUT) { const float* hin = (const float*)(P.ws + WS_HIN) + eidx + sp * 64 + r32; cr[sp] = hin[0]; ci[sp] = hin[32]; } else { cr[sp] = 0.f; ci[sp] = 0.f; } }
        bf16x8 bb[4];
#pragma unroll
        for (int t = 0; t < 4; ++t) bb[t] = BBF[(size_t)(combo * 4 + t) * 64 + lane];
        bf16x8 cm[8];
        if constexpr (WITH_OUT) {
#pragma unroll
            for (int ks = 0; ks < 8; ++ks) cm[ks] = CMF[(size_t)(combo * 8 + ks) * 64 + lane]; }
#pragma unroll
        for (int tbi = 0; tbi < 4; ++tbi) {
            const int tb = dir ? 3 - tbi : tbi;
#pragma unroll
            for (int sp = 0; sp < 2; ++sp) {
                f32x16 z = {}; f32x16 xr = MFMA32(ua[tb], bb[sp * 2 + 0], z), xi = MFMA32(ua[tb], bb[sp * 2 + 1], z);
                if (dir == 0) s5_scan_tile<false, WITH_OUT>(xr, xi, lr[sp], li[sp], l4r[sp], l4i[sp], cr[sp], ci[sp], h);
                else          s5_scan_tile<true,  WITH_OUT>(xr, xi, lr[sp], li[sp], l4r[sp], l4i[sp], cr[sp], ci[sp], h);
                if constexpr (WITH_OUT) {
                    s5_store_img(img, xr, r32, h); s5_store_img(img + 2304, xi, r32, h);
                    LDS_WAIT();
                    bf16x8 a0, a1;
                    s5_read_img(imgb, lane, a0, a1);        y[tb] = MFMA32(a0, cm[sp * 4 + 0], y[tb]); y[tb] = MFMA32(a1, cm[sp * 4 + 1], y[tb]);
                    s5_read_img(imgb + 2304, lane, a0, a1); y[tb] = MFMA32(a0, cm[sp * 4 + 2], y[tb]); y[tb] = MFMA32(a1, cm[sp * 4 + 3], y[tb]);
                }
            }
        }
        if constexpr (!WITH_OUT) { if (h == 0) { float* e = (float*)(P.ws + WS_E) + eidx;
#pragma unroll
            for (int sp = 0; sp < 2; ++sp) { e[sp * 64 + r32] = cr[sp]; e[sp * 64 + 32 + r32] = ci[sp]; } } }
    }
    if constexpr (WITH_OUT) {
        bf16* G = (bf16*)(P.ws + WS_QKV);
        if (r32 < 16) {
#pragma unroll
            for (int tb = 0; tb < 4; ++tb)
#pragma unroll
                for (int r = 0; r < 16; ++r) { const int row = row0 + 32 * tb + att::crow(r, h); G[(size_t)row * DM + 16 * g + r32] = (bf16)f2bf(gelu_tanh(y[tb][r])); }
        }
    }
}
template <bool WITH_OUT>
__device__ __forceinline__ void phase_s5_chunks(const Params& P, int j, LAS unsigned char* lds, int wave, int lane) {
    LAS unsigned char* img = lds + wave * 4096;
    for (int it = blockIdx.x; it < NBATCH * NCHUNK * 8; it += gridDim.x) {
        const int go = it & 7, bc = it >> 3, b = bc / NCHUNK, c = bc % NCHUNK;
        s5_chunk<WITH_OUT>(P, j, b, c, go * 8 + wave, lane, img);
    }
}
template <bool WITH_OUT> struct S5Item { bf16x8 au[4]; float cin[2][2][2]; };
template <bool WITH_OUT>
__device__ __forceinline__ void s5v2_load(const Params& P, int b, int c, int g, int lane, S5Item<WITH_OUT>& it) {
    const int r32 = lane & 31, h = lane >> 5; const bf16* H = (const bf16*)(P.ws + WS_H); const int row0 = b * RPB + c * 128;
#pragma unroll
    for (int r = 0; r < 4; ++r) it.au[r] = *(const bf16x8*)(H + (size_t)(row0 + 4 * r32 + r) * DM + 16 * g + 8 * h);
    if constexpr (WITH_OUT) {
#pragma unroll
        for (int dir = 0; dir < 2; ++dir) { const float* hin = (const float*)(P.ws + WS_HIN) + ((size_t)((b * NCHUNK + c) * 2 + dir) * 64 + g) * 128 + r32;
#pragma unroll
            for (int sp = 0; sp < 2; ++sp) { it.cin[dir][sp][0] = hin[sp * 64]; it.cin[dir][sp][1] = hin[sp * 64 + 32]; } }
    }
}
template <bool WITH_OUT>
__device__ __forceinline__ void s5v2_chunk(const Params& P, int j, int b, int c, int g, int lane, const LAS bf16x8* tab, LAS unsigned char* img, const S5Item<WITH_OUT>& it, const float (&lm)[2][2][4]) {
    const int r32 = lane & 31, h = lane >> 5;
    const int row0 = b * RPB + c * 128;
    f32x16 y[2];
    if constexpr (WITH_OUT) {
#pragma unroll
        for (int n = 0; n < 2; ++n) { f32x16 z = {}; y[n] = z; }
        bf16x8 ft[8];
#pragma unroll
        for (int q = 0; q < 8; ++q) ft[q] = tab[(64 + q) * 64 + lane];
        att::sbar_();
#pragma unroll
        for (int rp = 0; rp < 4; ++rp)
#pragma unroll
            for (int n = 0; n < 2; ++n) y[n] = MFMA32(it.au[rp], ft[rp * 2 + n], y[n]);
        att::sbar_();
    }
    const unsigned imgb = (unsigned)(uintptr_t)img;
#pragma unroll
    for (int dir = 0; dir < 2; ++dir) {
        const size_t eidx = ((size_t)((b * NCHUNK + c) * 2 + dir) * 64 + g) * 128;
        f32x16 X[4];
#pragma unroll
        for (int t = 0; t < 4; ++t) { f32x16 z = {}; X[t] = z; }
        bf16x8 as[4];
#pragma unroll
        for (int r = 0; r < 4; ++r) {
            as[r] = it.au[r];
            if constexpr (WITH_OUT) {
                const bool ok = dir == 0 ? (r32 > 0) : (r32 < 31); const int srcl = dir == 0 ? lane - 1 : lane + 1;
                v4u w = __builtin_bit_cast(v4u, it.au[r]); w.x = (unsigned)__shfl((int)w.x, srcl); w.y = (unsigned)__shfl((int)w.y, srcl); w.z = (unsigned)__shfl((int)w.z, srcl); w.w = (unsigned)__shfl((int)w.w, srcl);
                if (!ok) { w.x = 0u; w.y = 0u; w.z = 0u; w.w = 0u; }
                as[r] = __builtin_bit_cast(bf16x8, w);
            }
        }
        {
            bf16x8 fA[4], fB[4];
#pragma unroll
            for (int t = 0; t < 4; ++t) fA[t] = tab[(dir * 16 + 0 * 4 + t) * 64 + lane];
#pragma unroll
            for (int r = 0; r < 4; ++r) {
                if (r < 3) {
#pragma unroll
                    for (int t = 0; t < 4; ++t) { if (r & 1) fA[t] = tab[(dir * 16 + (r + 1) * 4 + t) * 64 + lane]; else fB[t] = tab[(dir * 16 + (r + 1) * 4 + t) * 64 + lane]; } }
                att::sbar_();
#pragma unroll
                for (int t = 0; t < 4; ++t) X[t] = MFMA32(as[r], (r & 1) ? fB[t] : fA[t], X[t]);
                att::sbar_();
            }
        }
#pragma unroll
        for (int sp = 0; sp < 2; ++sp) {
            const float l4r = lm[dir][sp][0], l4i = lm[dir][sp][1], l16r = lm[dir][sp][2], l16i = lm[dir][sp][3];
            float cr = 0.f, ci = 0.f;
            if constexpr (WITH_OUT) {
                const float kr = it.cin[dir][sp][0], ki = it.cin[dir][sp][1];
                if (dir == 0) { X[sp * 2][0] += h == 0 ? kr : 0.f; X[sp * 2 + 1][0] += h == 0 ? ki : 0.f; }
                else          { X[sp * 2][15] += h == 1 ? kr : 0.f; X[sp * 2 + 1][15] += h == 1 ? ki : 0.f; }
                if (dir == 0) s5_scan_tile<false, true>(X[sp * 2], X[sp * 2 + 1], l4r, l4i, l16r, l16i, cr, ci, h);
                else          s5_scan_tile<true,  true>(X[sp * 2], X[sp * 2 + 1], l4r, l4i, l16r, l16i, cr, ci, h);
                bf16x8 fw[8];
#pragma unroll
                for (int q = 0; q < 8; ++q) fw[q] = tab[(32 + dir * 16 + sp * 8 + q) * 64 + lane];
                s5_store_img(img, X[sp * 2], r32, h); s5_store_img(img + 2304, X[sp * 2 + 1], r32, h);
                LDS_WAIT();
                bf16x8 a0, a1, a2, a3;
                s5_read_img(imgb, lane, a0, a1); s5_read_img(imgb + 2304, lane, a2, a3);
#pragma unroll
                for (int n = 0; n < 2; ++n) { y[n] = MFMA32(a0, fw[0 + n], y[n]); y[n] = MFMA32(a1, fw[2 + n], y[n]); y[n] = MFMA32(a2, fw[4 + n], y[n]); y[n] = MFMA32(a3, fw[6 + n], y[n]); }
            } else {
                if (dir == 0) s5_scan_tile<false, false>(X[sp * 2], X[sp * 2 + 1], l4r, l4i, l16r, l16i, cr, ci, h);
                else          s5_scan_tile<true,  false>(X[sp * 2], X[sp * 2 + 1], l4r, l4i, l16r, l16i, cr, ci, h);
                if (h == 0) { float* e = (float*)(P.ws + WS_E) + eidx; e[sp * 64 + r32] = cr; e[sp * 64 + 32 + r32] = ci; }
            }
        }
    }
    if constexpr (WITH_OUT) {
        bf16* G = (bf16*)(P.ws + WS_QKV);
#pragma unroll
        for (int n = 0; n < 2; ++n)
#pragma unroll
            for (int r = 0; r < 16; ++r) { const int row = row0 + 4 * att::crow(r, h) + 2 * n + (r32 >> 4); G[(size_t)row * DM + 16 * g + (r32 & 15)] = (bf16)f2bf(gelu_tanh(y[n][r])); }
    }
}
template <bool WITH_OUT>
__device__ __forceinline__ void phase_s5v2(const Params& P, int j, LAS unsigned char* lds, int tid, int wave, int lane) {
    const int g = ((blockIdx.x & 7) << 3) | ((blockIdx.x >> 3) & 7), q = blockIdx.x >> 6;
    auto item_bc = [&](int k, int& b, int& c) { if (k < 8) { const int o = q + 4 * k; b = o >> 4; c = 2 + 8 * (o & 15) + wave; } else { b = q >> 1; c = q & 1; } };
    S5Item<WITH_OUT> cur, nxt; int b, c; item_bc(0, b, c); s5v2_load<WITH_OUT>(P, b, c, g, lane, cur);
    LAS v4u* tabw = (LAS v4u*)lds; const v4u* src = (const v4u*)(P.ws + WS_S5T) + (size_t)(j * 64 + g) * 72 * 64;
    for (int i = tid; i < 64 * 64; i += NTHREADS) tabw[i] = src[i];
    { const float* KT = (const float*)(P.ws + WS_KT) + (size_t)(j * 64 + g) * 2048;
      const int qq = tid >> 6, l = tid & 63, rp = qq >> 1, n = qq & 1, r = 2 * n + ((l & 31) >> 4), c = l & 15, c0 = 8 * (l >> 5);
      float v[8];
      if (rp != r) { const float* k = KT + (size_t)((rp < r ? 0 : 1) * 4 + (rp < r ? r - rp : rp - r)) * 256 + c * 16 + c0;
#pragma unroll
          for (int jj = 0; jj < 8; ++jj) v[jj] = k[jj]; }
      else { const float* kf = KT + c * 16 + c0; const float* kb = KT + 4 * 256 + c * 16 + c0;
#pragma unroll
          for (int jj = 0; jj < 8; ++jj) v[jj] = kf[jj] + kb[jj] + (c == c0 + jj ? P.in[I_S5D][j * DM + 16 * g + c] : 0.f); }
      v4u o; o.x = pk2(v[0], v[1]); o.y = pk2(v[2], v[3]); o.z = pk2(v[4], v[5]); o.w = pk2(v[6], v[7]);
      tabw[(64 + qq) * 64 + l] = o; }
    float lm[2][2][4];
    { const float* LAM = (const float*)(P.ws + WS_LAM); const int r32 = lane & 31;
#pragma unroll
      for (int dir = 0; dir < 2; ++dir)
#pragma unroll
        for (int sp = 0; sp < 2; ++sp) { const int combo = (j * 2 + dir) * 64 + g;
            const float l1r = LAM[(size_t)(combo * 2 + 0) * 64 + sp * 32 + r32], l1i = LAM[(size_t)(combo * 2 + 1) * 64 + sp * 32 + r32];
            const float l2r = l1r * l1r - l1i * l1i, l2i = 2.f * l1r * l1i, l4r = l2r * l2r - l2i * l2i, l4i = 2.f * l2r * l2i;
            const float l8r = l4r * l4r - l4i * l4i, l8i = 2.f * l4r * l4i;
            lm[dir][sp][0] = l4r; lm[dir][sp][1] = l4i; lm[dir][sp][2] = l8r * l8r - l8i * l8i; lm[dir][sp][3] = 2.f * l8r * l8i; } }
    __syncthreads();
    const LAS bf16x8* tab = (const LAS bf16x8*)lds; LAS unsigned char* img = lds + 73728 + wave * 4608;
    const int nit = 8 + (wave == 0 ? 1 : 0);
    for (int k = 0; k < nit; ++k) {
        int bn = b, cn = c;
        if (k + 1 < nit) { item_bc(k + 1, bn, cn); s5v2_load<WITH_OUT>(P, bn, cn, g, lane, nxt); }
        s5v2_chunk<WITH_OUT>(P, j, b, c, g, lane, tab, img, cur, lm);
        cur = nxt; b = bn; c = cn;
    }
}
__device__ __forceinline__ void phase_s5_carry(const Params& P, int j, LAS unsigned char* lds, int tid, int wave, int lane) {
    const float* LAM = (const float*)(P.ws + WS_LAM); const float* __restrict__ E = (const float*)(P.ws + WS_E); float* __restrict__ HIN = (float*)(P.ws + WS_HIN);
    LAS float* es = (LAS float*)lds;
    for (int it = blockIdx.x; it < NBATCH * 2 * 64; it += gridDim.x) {
        const int b = it >> 7, dir = (it >> 6) & 1, g = it & 63, combo = (j * 2 + dir) * 64 + g;
        __syncthreads();
        for (int i = tid; i < NCHUNK * 32; i += NTHREADS) { const int c = i >> 5, q = i & 31;
            ((LAS f32x4*)es)[i] = *(const f32x4*)(E + ((size_t)((b * NCHUNK + c) * 2 + dir) * 64 + g) * 128 + 4 * q); }
        __syncthreads();
        if (wave == 0) {
            float pr = LAM[(size_t)(combo * 2 + 0) * 64 + lane], pi = LAM[(size_t)(combo * 2 + 1) * 64 + lane];
#pragma unroll
            for (int s_ = 0; s_ < 7; ++s_) { const float nr = pr * pr - pi * pi, ni = 2.f * pr * pi; pr = nr; pi = ni; }
            const int lo = (lane >> 5) * 64 + (lane & 31);
            float hr = 0.f, hi = 0.f;
#pragma unroll 5
            for (int s_ = 0; s_ < NCHUNK; ++s_) { const int c = dir == 0 ? s_ : (s_ < 2 ? 1 - s_ : NCHUNK + 1 - s_);
                const size_t ix = ((size_t)((b * NCHUNK + c) * 2 + dir) * 64 + g) * 128 + lo;
                HIN[ix] = hr; HIN[ix + 32] = hi;
                const float er = es[c * 128 + lo], ei = es[c * 128 + lo + 32];
                const float nr = fmaf(pr, hr, fmaf(-pi, hi, er)), ni = fmaf(pr, hi, fmaf(pi, hr, ei)); hr = nr; hi = ni; }
        }
    }
}
template <bool GLU>
__device__ __forceinline__ void ctx_gemm(const bf16* __restrict__ A, const bf16* __restrict__ Bt, int ncols_out, bf16* __restrict__ O, int ldc, LAS unsigned char* lds, int wave, int lane) {
    const int r32 = lane & 31, h = lane >> 5, nct = ncols_out >> 5, ntile = 16 * nct, kq = wave & 3, tsel = wave >> 2;
    LAS float* part = (LAS float*)lds;
    for (int t0 = blockIdx.x * 2; t0 < ntile; t0 += gridDim.x * 2) {
        const int it = t0 + tsel; const bool valid = it < ntile;
        const int rt = valid ? it / nct : 0, ct = valid ? it - rt * nct : 0, row0 = (rt >> 3) * RPB + (rt & 7) * 32, col0 = ct * 32;
        if (valid) {
            const bf16* ap = A + (size_t)(row0 + r32) * DM + 8 * h + 256 * kq;
            const bf16* bp = Bt + (size_t)((GLU ? glu_row(col0, 0) : col0) + r32) * DM + 8 * h + 256 * kq; const bf16* gp = bp + (size_t)128 * DM;
            f32x16 acc = {}, accg = {};
#pragma unroll
            for (int ks = 0; ks < 16; ++ks) { const bf16x8 a = *(const bf16x8*)(ap + 16 * ks), b = *(const bf16x8*)(bp + 16 * ks); acc = MFMA32(a, b, acc);
                if constexpr (GLU) { const bf16x8 g = *(const bf16x8*)(gp + 16 * ks); accg = MFMA32(a, g, accg); } }
            LAS float* pp = part + (size_t)((tsel * 4 + kq) * 2) * 1024 + lane;
#pragma unroll
            for (int r = 0; r < 16; ++r) { pp[r * 64] = acc[r]; if constexpr (GLU) pp[1024 + r * 64] = accg[r]; }
        }
        __syncthreads();
        if (valid) {
#pragma unroll
            for (int rr = 0; rr < 4; ++rr) { const int r = 4 * kq + rr; float v = 0.f, g = 0.f;
#pragma unroll
                for (int q = 0; q < 4; ++q) { const LAS float* pp = part + (size_t)((tsel * 4 + q) * 2) * 1024 + r * 64 + lane; v += pp[0]; if constexpr (GLU) g += pp[1024]; }
                if constexpr (GLU) v *= pg8::sigmoidf_fast(g);
                O[(size_t)(row0 + att::crow(r, h)) * ldc + col0 + r32] = (bf16)f2bf(v); }
        }
        __syncthreads();
    }
}

__device__ __forceinline__ void phase_rope_swa(const Params& P, int wave, int lane, bf16* qdummy = nullptr) {
    const int gw = blockIdx.x * NWAVES + wave, ngw = gridDim.x * NWAVES;
    bf16* QKV = (bf16*)(P.ws + WS_QKV); const float* cosB = (const float*)(P.ws + WS_ROPE); const float* sinB = cosB + 4096;
    for (int row = gw; row < NR; row += ngw) {
        const int b = row >= RPB ? 1 : 0, rr = row - b * RPB; if (rr < NCTX) continue;
        const int t = rr - NCTX; bf16* q = QKV + (size_t)row * QKV_B;
        float x1[9], x2[9], c[9], s[9];
#pragma unroll
        for (int it = 0; it < 9; ++it) { const int pi = lane + 64 * it, blk = pi >> 4, i = pi & 15, col = blk * 32 + i, pos = (blk & 1) ? (t & 63) : (t >> 6);
            c[it] = cosB[pos * 16 + i]; s[it] = sinB[pos * 16 + i]; x1[it] = bf2f(q[col]); x2[it] = bf2f(q[col + 16]); }
#pragma unroll
        for (int it = 0; it < 9; ++it) { const int pi = lane + 64 * it, blk = pi >> 4, i = pi & 15, col = blk * 32 + i;
            bf16* qo = qdummy ? qdummy + (size_t)row * QKV_B : q; qo[col] = (bf16)f2bf(x1[it] * c[it] - x2[it] * s[it]); qo[col + 16] = (bf16)f2bf(x2[it] * c[it] + x1[it] * s[it]); }
    }
}
__device__ __forceinline__ void phase_normrope_gqa(const Params& P, int wave, int lane, bf16* qdummy = nullptr) {
    const int gw = blockIdx.x * NWAVES + wave, ngw = gridDim.x * NWAVES;
    bf16* QKV = (bf16*)(P.ws + WS_QKV); const float* cosC = (const float*)(P.ws + WS_ROPE) + 8192; const float* sinC = cosC + 8192;
    const int a = lane >> 5, i = lane & 31, d1 = a * 64 + i, d2 = d1 + 32;
    const float gk1 = P.in[I_KNORM][d1], gk2 = P.in[I_KNORM][d2];
    constexpr int NB = 11;
    for (int it0 = gw; it0 < NR * 2; it0 += NB * ngw) {
        float x1[NB], x2[NB], c[NB], s[NB];
#pragma unroll
        for (int k = 0; k < NB; ++k) { const int it = it0 + k * ngw < NR * 2 ? it0 + k * ngw : it0; const int row = it >> 1, hd = 8 + (it & 1);
            const int b = row >= RPB ? 1 : 0, rr = row - b * RPB; const bool lat = rr >= NCTX; const int t = rr - NCTX;
            c[k] = 1.f; s[k] = 0.f;
            if (lat) { const int pos = a ? (t & 63) : (t >> 6); c[k] = cosC[pos * 32 + i]; s[k] = sinC[pos * 32 + i]; }
            const bf16* q = QKV + (size_t)row * QKV_C + hd * 128; x1[k] = bf2f(q[d1]); x2[k] = bf2f(q[d2]); }
#pragma unroll
        for (int k = 0; k < NB; ++k) { const int it = it0 + k * ngw; const bool ok = it < NR * 2; const int itc = ok ? it : it0, row = itc >> 1, hd = 8 + (itc & 1);
            bf16* qo = (qdummy ? qdummy : QKV) + (size_t)row * QKV_C + hd * 128;
            const float ss = wave_sum(x1[k] * x1[k] + x2[k] * x2[k]), rstd = 1.0f / sqrtf(ss * (1.0f / 128.f) + RMS_EPS);
            const float n1 = x1[k] * rstd * gk1, n2 = x2[k] * rstd * gk2;
            if (ok) { qo[d1] = (bf16)f2bf(n1 * c[k] - n2 * s[k]); qo[d2] = (bf16)f2bf(n2 * c[k] + n1 * s[k]); } }
    }
}

__device__ __forceinline__ int vt_key(int pos) { const int ks = pos >> 4, h = (pos >> 3) & 1, e = pos & 7; return 32 * (ks >> 1) + 16 * (ks & 1) + 8 * (e >> 2) + 4 * h + (e & 3); }
__device__ __forceinline__ void phase_vt_gqa(const Params& P, LAS unsigned char* lds, int wave, int lane) {
    if (wave >= 7) return;
    const int gw = blockIdx.x * 7 + wave, ngw = gridDim.x * 7;
    const bf16* QKV = (const bf16*)(P.ws + WS_QKV); bf16* VT = (bf16*)(P.ws + WS_VT);
    LAS unsigned short* T = (LAS unsigned short*)(lds + wave * 16640);
    for (int it = gw; it < NBATCH * 2 * (RPB / 64); it += ngw) {
        const int j = it % (RPB / 64), bk = it / (RPB / 64), b = bk >> 1, kvh = bk & 1;
        const bf16* src = QKV + ((size_t)b * RPB + 64 * j) * QKV_C + 1280 + kvh * 128;
        v4u vv[16];
#pragma unroll
        for (int i = 0; i < 16; ++i) { const int chunk = i * 64 + lane, key = chunk >> 4, c = chunk & 15; vv[i] = __builtin_nontemporal_load((const v4u*)(src + (size_t)key * QKV_C + 8 * c)); }
#pragma unroll
        for (int i = 0; i < 16; ++i) { const int chunk = i * 64 + lane, key = chunk >> 4, c = chunk & 15;
            LAS unsigned* d = (LAS unsigned*)(T + key * 130 + 8 * c); d[0] = vv[i].x; d[1] = vv[i].y; d[2] = vv[i].z; d[3] = vv[i].w; }
        LDS_WAIT(); asm volatile("" ::: "memory");
        bf16* dst = VT + ((size_t)bk * 128) * RPB + 64 * j;
        const int dl = lane >> 3, c = lane & 7;
#pragma unroll 4
        for (int i = 0; i < 16; ++i) { const int d = 8 * i + dl; unsigned w[4];
#pragma unroll
            for (int e = 0; e < 4; ++e) { const unsigned lo = T[vt_key(8 * c + 2 * e) * 130 + d], hi = T[vt_key(8 * c + 2 * e + 1) * 130 + d]; w[e] = lo | (hi << 16); }
            v4u o; o.x = w[0]; o.y = w[1]; o.z = w[2]; o.w = w[3]; *(v4u*)(dst + (size_t)d * RPB + 8 * c) = o; }
        LDS_WAIT(); asm volatile("" ::: "memory");
    }
}

__device__ __forceinline__ void phase_attn_swa(const Params& P, LAS unsigned char* lds, int tid_in) {
    const bf16* QKV = (const bf16*)(P.ws + WS_QKV); bf16* O = (bf16*)(P.ws + WS_O);
    for (int u = blockIdx.x; u < 2048 + 32; u += gridDim.x) {
        int h, b, qb, nt; size_t rq;
        if (u < 2048) { h = u & 15; qb = (u >> 4) & 63; b = u >> 10; nt = 12; rq = (size_t)b * RPB + NCTX + qb * 256; }
        else { const int v = u - 2048; h = v & 15; b = v >> 4; qb = 0; nt = 4; rq = (size_t)b * RPB; }
        const int kvh = h >> 3; const size_t r0 = (size_t)b * RPB;
        att::attn_unit<64, true, QKV_B, QKV_B, DM, SEQ>(QKV + rq * QKV_B + h * 64, QKV + r0 * QKV_B + 1024 + kvh * 64, QKV + r0 * QKV_B + 1152 + kvh * 64,
                                                        O + rq * DM + h * 64, nt, qb * 256, true, P.in[I_SINK][h], (char*)lds, tid_in);
    }
}
__device__ __forceinline__ void phase_attn_gqa(const Params& P, LAS unsigned char* lds, int tid_in) {
    const bf16* QKV = (const bf16*)(P.ws + WS_QKV); bf16* O = (bf16*)(P.ws + WS_O);
    bool nomax;
    { const int l = hw_lane(); float mq = fmaxf(fabsf(P.in[I_QNORM][l]), fabsf(P.in[I_QNORM][64 + l])), mk = fmaxf(fabsf(P.in[I_KNORM][l]), fabsf(P.in[I_KNORM][64 + l]));
#pragma unroll
      for (int o = 1; o < 64; o <<= 1) { mq = fmaxf(mq, __shfl_xor(mq, o)); mk = fmaxf(mk, __shfl_xor(mk, o)); }
      nomax = __builtin_amdgcn_readfirstlane((11.313708498984761f * 1.03f * mq * mk < 40.f) ? 1 : 0) != 0; }
    for (int u = blockIdx.x; u < 1024 + 16; u += gridDim.x) {
        int h, b, nt; size_t rq;
        if (u < 1024) { const int bk = u >> 8, rem = u & 255; b = bk >> 1; h = (bk & 1) * 4 + (rem >> 6); nt = RPB / 64; rq = (size_t)b * RPB + NCTX + (rem & 63) * 256; }
        else { const int v = u - 1024; h = v & 7; b = v >> 3; nt = 4; rq = (size_t)b * RPB; }
        const int kvh = h >> 2; const size_t r0 = (size_t)b * RPB;
        const float* cosC = (const float*)(P.ws + WS_ROPE) + 8192; const int tq0 = u < 1024 ? (int)(rq - r0) - NCTX : -1;
        if (nomax) att::attn_unit<128, false, QKV_C, QKV_C, DM, SEQ, true, true>(QKV + rq * QKV_C + h * 128, QKV + r0 * QKV_C + 1024 + kvh * 128, QKV + r0 * QKV_C + 1280 + kvh * 128,
                                                                               O + rq * DM + h * 128, nt, 0, false, 0.f, (char*)lds, tid_in, P.in[I_QNORM], cosC, cosC + 8192, tq0,
                                                                               (const bf16*)(P.ws + WS_VT) + (size_t)((b * 2 + kvh) * 128) * RPB, RPB);
        else       att::attn_unit<128, false, QKV_C, QKV_C, DM, SEQ, false, true>(QKV + rq * QKV_C + h * 128, QKV + r0 * QKV_C + 1024 + kvh * 128, QKV + r0 * QKV_C + 1280 + kvh * 128,
                                                                                O + rq * DM + h * 128, nt, 0, false, 0.f, (char*)lds, tid_in, P.in[I_QNORM], cosC, cosC + 8192, tq0);
    }
}

__device__ __forceinline__ void phase_ln1(const Params& P, int layer, LAS unsigned char* lds, int tid, int wave, int lane, float* xdummy = nullptr) {
    LAS float* rwT = (LAS float*)lds; LAS int* cnt = (LAS int*)(lds + 65536); LAS float* lg = (LAS float*)(lds + 65536 + 256) + wave * 32;
    const int vb = blockIdx.x;
    const float* MOD = (const float*)(P.ws + WS_MOD); bf16* H = (bf16*)(P.ws + WS_H); const bf16* Y = (const bf16*)(P.ws + WS_Y);
    bf16* X = (bf16*)(P.ws + WS_X); unsigned* ROUTE = (unsigned*)(P.ws + WS_ROUTE);
    const float* lng = P.in[I_LNG] + (size_t)(layer * 2 + 0) * DM; const float* lnb = P.in[I_LNB] + (size_t)(layer * 2 + 0) * DM;
    auto xload = [&](int row, f32x4 (&xo)[4]) { const int b = row >= RPB ? 1 : 0, rr = row - b * RPB;
        if (layer == 0) { const float* xs = rr < NCTX ? P.in[I_CTX] + (size_t)(b * NCTX + rr) * DM : P.in[I_X] + (size_t)(b * SEQ + rr - NCTX) * DM;
#pragma unroll
            for (int j = 0; j < 4; ++j) xo[j] = __builtin_nontemporal_load((const f32x4*)(xs + 4 * lane + 256 * j)); }
        else {
#pragma unroll
            for (int j = 0; j < 4; ++j) { const v2u w = __builtin_nontemporal_load((const v2u*)(X + (size_t)row * DM + 4 * lane + 256 * j)); xo[j] = (f32x4){bflo(w.x), bfhi(w.x), bflo(w.y), bfhi(w.y)}; } } };
    f32x4 xn_[4]; v2u yn_[4];
    { const int row = vb * 130 + wave; xload(row, xn_);
#pragma unroll
      for (int j = 0; j < 4; ++j) yn_[j] = __builtin_nontemporal_load((const v2u*)(Y + (size_t)row * DM + 4 * lane + 256 * j)); }
    for (int idx = tid; idx < DM * NEXP; idx += NTHREADS) rwT[(idx & 15) * DM + (idx >> 4)] = P.in[I_RW][idx];
    if (tid < NEXP) cnt[tid] = 0;
    __syncthreads();
    auto ln_row = [&](int ri, f32x4 (&hv)[4]) {
        const int row = vb * 130 + ri, b = row >= RPB ? 1 : 0, rr = row - b * RPB; const bool isctx = rr < NCTX;
        bf16* xd = xdummy ? (bf16*)xdummy + (size_t)row * DM : X + (size_t)row * DM;
        const float* mod = MOD + (size_t)(layer * 3 + (isctx ? 2 : b)) * 6144;
        f32x4 v[4]; float s = 0.f;
#pragma unroll
        for (int j = 0; j < 4; ++j) { const int col = 4 * lane + 256 * j; const f32x4 x = xn_[j], gt = *(const f32x4*)(mod + 2048 + col); const v2u yy = yn_[j];
            v[j][0] = fmaf(ALPHA, x[0], gt[0] * bflo(yy.x)); v[j][1] = fmaf(ALPHA, x[1], gt[1] * bfhi(yy.x)); v[j][2] = fmaf(ALPHA, x[2], gt[2] * bflo(yy.y)); v[j][3] = fmaf(ALPHA, x[3], gt[3] * bfhi(yy.y));
            s += (v[j][0] + v[j][1]) + (v[j][2] + v[j][3]); }
        if (ri + 8 < 130) { const int rown = row + 8; xload(rown, xn_);
#pragma unroll
            for (int j = 0; j < 4; ++j) yn_[j] = __builtin_nontemporal_load((const v2u*)(Y + (size_t)rown * DM + 4 * lane + 256 * j)); }
        const float mean = wave_sum(s) * (1.f / DM); float s2 = 0.f;
#pragma unroll
        for (int j = 0; j < 4; ++j) { v[j] = v[j] - mean; s2 += (v[j][0] * v[j][0] + v[j][1] * v[j][1]) + (v[j][2] * v[j][2] + v[j][3] * v[j][3]); }
        const float rstd = 1.0f / sqrtf(wave_sum(s2) * (1.f / DM) + LN_EPS);
#pragma unroll
        for (int j = 0; j < 4; ++j) { const int col = 4 * lane + 256 * j; const f32x4 lgv = *(const f32x4*)(lng + col), lbv = *(const f32x4*)(lnb + col), shv = *(const f32x4*)(mod + 3072 + col), scv = *(const f32x4*)(mod + 4096 + col);
            f32x4 xn = v[j] * rstd * lgv + lbv; f32x4 h2 = xn * scv + xn + shv; hv[j] = h2; v[j] = xn; }
#pragma unroll
        for (int j = 0; j < 4; ++j) { const int col = 4 * lane + 256 * j; v2u xo; xo.x = pk2(v[j][0], v[j][1]); xo.y = pk2(v[j][2], v[j][3]); __builtin_nontemporal_store(xo, (v2u*)(xd + col));
            v2u o; o.x = pk2(hv[j][0], hv[j][1]); o.y = pk2(hv[j][2], hv[j][3]); *(v2u*)(H + (size_t)row * DM + col) = o; }
    };
    for (int k = 0; k < 17; k += 2) {
        const int ri0 = wave + 8 * k, ri1 = ri0 + 8; if (ri0 >= 130) break;
        const bool two = ri1 < 130;
        f32x4 hvA[4], hvB[4];
        ln_row(ri0, hvA);
        asm volatile("" ::: "memory");
        if (two) ln_row(ri1, hvB); else {
#pragma unroll
            for (int j = 0; j < 4; ++j) hvB[j] = hvA[j]; }
        asm volatile("" ::: "memory");
        float pA[NEXP], pB[NEXP];
#define LN1_ROUTER(TWO_) do { _Pragma("unroll") for (int e = 0; e < NEXP; ++e) { pg8::f32x2 qa = {0.f, 0.f}, qb = {0.f, 0.f}; \
            _Pragma("unroll") for (int j = 0; j < 4; ++j) { const f32x4 w = *(const LAS f32x4*)(rwT + e * DM + 4 * lane + 256 * j); \
                const pg8::f32x2 w01 = {w[0], w[1]}, w23 = {w[2], w[3]}; \
                qa = __builtin_elementwise_fma((pg8::f32x2){hvA[j][0], hvA[j][1]}, w01, qa); qa = __builtin_elementwise_fma((pg8::f32x2){hvA[j][2], hvA[j][3]}, w23, qa); \
                if (TWO_) { qb = __builtin_elementwise_fma((pg8::f32x2){hvB[j][0], hvB[j][1]}, w01, qb); qb = __builtin_elementwise_fma((pg8::f32x2){hvB[j][2], hvB[j][3]}, w23, qb); } } \
            pA[e] = qa.x + qa.y; pB[e] = qb.x + qb.y; \
            if (e & 1) asm volatile("" ::: "memory"); } } while (0)
        float ta, tb = 0.f;
        if (two) { LN1_ROUTER(true); ta = fold16(pA, lane); tb = fold16(pB, lane); } else { LN1_ROUTER(false); ta = fold16(pA, lane); }
#undef LN1_ROUTER
        { if ((lane & 3) == 0) { const int ei = 8 * ((lane >> 5) & 1) + 4 * ((lane >> 4) & 1) + 2 * ((lane >> 3) & 1) + ((lane >> 2) & 1); lg[ei] = ta; lg[16 + ei] = tb; } }
        LDS_WAIT(); asm volatile("" ::: "memory");
        {
            const int r = lane & 1;
            const int row = vb * 130 + ri0 + 8 * r;
            float aff[NEXP], sel[NEXP];
#pragma unroll
            for (int q = 0; q < 4; ++q) { const f32x4 t = *(const LAS f32x4*)(lg + r * 16 + 4 * q);
#pragma unroll
                for (int i = 0; i < 4; ++i) { aff[4 * q + i] = __builtin_amdgcn_rcpf(1.0f + __builtin_amdgcn_exp2f(-1.4426950408889634f * t[i])); sel[4 * q + i] = aff[4 * q + i] + P.in[I_RB][4 * q + i]; } }
            float bestgs = 0.f; int bg = 0;
#pragma unroll
            for (int gi = 0; gi < 4; ++gi) { const float s0 = sel[4 * gi], s1 = sel[4 * gi + 1], s2_ = sel[4 * gi + 2], s3 = sel[4 * gi + 3];
                const float gs = fmaxf(fmaxf(fmaxf(s0 + s1, s0 + s2_), fmaxf(s0 + s3, s1 + s2_)), fmaxf(s1 + s3, s2_ + s3));
                if (gi == 0 || gs > bestgs) { bestgs = gs; bg = gi; } }
            float a0 = aff[0], a1 = aff[1], a2 = aff[2], a3 = aff[3], q0 = sel[0], q1 = sel[1], q2 = sel[2], q3 = sel[3];
#pragma unroll
            for (int gi = 1; gi < 4; ++gi) if (bg == gi) { a0 = aff[4 * gi]; a1 = aff[4 * gi + 1]; a2 = aff[4 * gi + 2]; a3 = aff[4 * gi + 3]; q0 = sel[4 * gi]; q1 = sel[4 * gi + 1]; q2 = sel[4 * gi + 2]; q3 = sel[4 * gi + 3]; }
            int i0 = 0; float m0 = q0, g0 = a0;
            if (q1 > m0) { m0 = q1; i0 = 1; g0 = a1; } if (q2 > m0) { m0 = q2; i0 = 2; g0 = a2; } if (q3 > m0) { m0 = q3; i0 = 3; g0 = a3; }
            int i1 = -1; float m1 = 0.f, g1 = 0.f;
            if (i0 != 0) { m1 = q0; i1 = 0; g1 = a0; }
            if (i0 != 1 && (i1 < 0 || q1 > m1)) { m1 = q1; i1 = 1; g1 = a1; }
            if (i0 != 2 && (i1 < 0 || q2 > m1)) { m1 = q2; i1 = 2; g1 = a2; }
            if (i0 != 3 && (i1 < 0 || q3 > m1)) { m1 = q3; i1 = 3; g1 = a3; }
            const float inv = 1.0f / (g0 + g1);
            if (lane < (two ? 2 : 1)) { const int e0 = 4 * bg + i0, e1 = 4 * bg + i1; unsigned* rt = ROUTE + (size_t)row * 8;
                rt[0] = (unsigned)e0; rt[1] = (unsigned)e1; rt[2] = __float_as_uint(g0 * inv); rt[3] = __float_as_uint(g1 * inv);
                __hip_atomic_fetch_add(&cnt[e0], 1, __ATOMIC_RELAXED, __HIP_MEMORY_SCOPE_WORKGROUP); __hip_atomic_fetch_add(&cnt[e1], 1, __ATOMIC_RELAXED, __HIP_MEMORY_SCOPE_WORKGROUP); }
        }
        LDS_WAIT(); asm volatile("" ::: "memory");
    }
    __syncthreads();
    if (tid < NEXP) ((int*)(P.ws + WS_CNTB))[vb * NEXP + tid] = cnt[tid];
}
__device__ __forceinline__ void phase_dispatch(const Params& P, LAS unsigned char* lds, int tid, int wave, int lane) {
    LAS int* cl = (LAS int*)lds;
    LAS int* tot = cl + NGRID * NEXP; LAS int* base = tot + 16; LAS int* ent = tot + 64;
    LAS float* gts = (LAS float*)(ent + 320);
    const int vb = blockIdx.x; const int* cntb = (const int*)(P.ws + WS_CNTB);
    unsigned* ROUTE = (unsigned*)(P.ws + WS_ROUTE); int* pane = (int*)(P.ws + WS_PANE);
    for (int i = tid; i < NGRID * NEXP; i += NTHREADS) cl[i] = cntb[i];
    if (tid < 260) { const unsigned* rt = ROUTE + (size_t)(vb * 130 + (tid >> 1)) * 8; ent[tid] = (int)rt[tid & 1]; gts[tid] = __uint_as_float(rt[2 + (tid & 1)]); }
    __syncthreads();
    { LAS int* part = ent + 1024;
      const int e = tid & 15, pt = tid >> 4; int t = 0, bf = 0;
#pragma unroll
      for (int k = 0; k < 8; ++k) { const int b2 = 8 * pt + k, c = cl[b2 * NEXP + e]; t += c; bf += b2 < vb ? c : 0; }
      part[pt * 16 + e] = t; part[512 + pt * 16 + e] = bf; }
    __syncthreads();
    if (tid < NEXP) { LAS int* part = ent + 1024; int t = 0, bf = 0;
#pragma unroll
        for (int pt = 0; pt < 32; ++pt) { t += part[pt * 16 + tid]; bf += part[512 + pt * 16 + tid]; } tot[tid] = t; base[tid] = bf; }
    __syncthreads();
    if (wave == 0) {
        int off = 0, mybase = 0;
        for (int e = 0; e < NEXP; ++e) { const int np = (tot[e] + 255) >> 8; if (lane == e) mybase = off + base[e];
            if (vb == 0) for (int p = lane; p < np; p += 64) pane[16 + (off >> 8) + p] = e;
            off += np << 8; }
        if (vb == 0 && lane == 0) pane[0] = off >> 8;
        for (int q = 0; q < 5; ++q) { const int i = q * 64 + lane; const bool act = i < 260; const int me = act ? ent[i] : -1; int mypos = 0;
#pragma unroll
            for (int e = 0; e < NEXP; ++e) { const unsigned long long mk = __ballot(me == e); const int be = __shfl(mybase, e);
                if (me == e) mypos = be + __popcll(mk & ((1ull << lane) - 1ull));
                if (lane == e) mybase += __popcll(mk); }
            if (act) { ent[i] = mypos; ROUTE[(size_t)(vb * 130 + (i >> 1)) * 8 + 4 + (i & 1)] = (unsigned)mypos; } }
    }
    __syncthreads();
    float* gs = (float*)(P.ws + WS_GSLOT); int* rowmap = (int*)(P.ws + WS_ROWMAP);
    if (tid < 260) { const int p = ent[tid]; rowmap[p] = vb * 130 + (tid >> 1); gs[p] = gts[tid]; }
    if (vb == 0) {
        int off = 0;
        for (int e = 0; e < NEXP; ++e) { const int t = tot[e], np = (t + 255) >> 8; for (int p = t + tid; p < (np << 8); p += NTHREADS) rowmap[off + p] = 0; off += np << 8; }
    }
}
__device__ __forceinline__ void phase_ln2(const Params& P, int layer, int wave, int lane, float* xdummy = nullptr) {
    const int gw = blockIdx.x * NWAVES + wave, ngw = gridDim.x * NWAVES;
    const float* MOD = (const float*)(P.ws + WS_MOD); bf16* H = (bf16*)(P.ws + WS_H); const bf16* YS = (const bf16*)(P.ws + WS_HS);
    bf16* X = (bf16*)(P.ws + WS_X); const unsigned* ROUTE = (const unsigned*)(P.ws + WS_ROUTE);
    const float* lng = P.in[I_LNG] + (size_t)(layer * 2 + 1) * DM; const float* lnb = P.in[I_LNB] + (size_t)(layer * 2 + 1) * DM;
    constexpr int NRW = 6;
    unsigned pn0[NRW], pn1[NRW];
#pragma unroll
    for (int r = 0; r < NRW; ++r) { const int rw = gw + r * ngw; const unsigned* rt = ROUTE + (size_t)(rw < NR ? rw : gw) * 8; pn0[r] = rt[4]; pn1[r] = rt[5]; }
    for (int row0 = gw; row0 < NR; row0 += NRW * ngw) {
        int row[NRW]; bool ok[NRW]; v4u xw[NRW][2], ya[NRW][2], yb[NRW][2];
#pragma unroll
        for (int r = 0; r < NRW; ++r) { ok[r] = row0 + r * ngw < NR; row[r] = ok[r] ? row0 + r * ngw : row0;
            const bf16* xr = X + (size_t)row[r] * DM + 8 * lane; const bf16* y0 = YS + (size_t)pn0[r] * DM + 8 * lane; const bf16* y1 = YS + (size_t)pn1[r] * DM + 8 * lane;
#pragma unroll
            for (int c = 0; c < 2; ++c) { xw[r][c] = __builtin_nontemporal_load((const v4u*)(xr + 512 * c)); ya[r][c] = __builtin_nontemporal_load((const v4u*)(y0 + 512 * c)); yb[r][c] = __builtin_nontemporal_load((const v4u*)(y1 + 512 * c)); } }
#pragma unroll
        for (int r = 0; r < NRW; ++r) { const int rw = row0 + (NRW + r) * ngw; const unsigned* rt = ROUTE + (size_t)(rw < NR ? rw : gw) * 8; pn0[r] = rt[4]; pn1[r] = rt[5]; }
        f32x4 lgv[4], lbv[4];
#pragma unroll
        for (int c = 0; c < 2; ++c)
#pragma unroll
            for (int q = 0; q < 2; ++q) { const int col = 8 * lane + 512 * c + 4 * q; lgv[2 * c + q] = *(const f32x4*)(lng + col); lbv[2 * c + q] = *(const f32x4*)(lnb + col); }
#pragma unroll
        for (int r = 0; r < NRW; ++r) {
            if (!ok[r]) continue;
            const int b = row[r] >= RPB ? 1 : 0, rr = row[r] - b * RPB, cond = rr < NCTX ? 2 : b;
            const float* mod = MOD + (size_t)(layer * 3 + cond) * 6144; const float* modn = MOD + (size_t)((layer < 3 ? layer + 1 : 3) * 3 + cond) * 6144;
            f32x4 v[4]; float s = 0.f;
#pragma unroll
            for (int c = 0; c < 2; ++c)
#pragma unroll
                for (int q = 0; q < 2; ++q) { const int col = 8 * lane + 512 * c + 4 * q; const f32x4 gt = *(const f32x4*)(mod + 5120 + col);
                    const unsigned x0 = xw[r][c][2 * q], x1 = xw[r][c][2 * q + 1], a0 = ya[r][c][2 * q], a1 = ya[r][c][2 * q + 1], b0 = yb[r][c][2 * q], b1 = yb[r][c][2 * q + 1];
                    f32x4& o = v[2 * c + q];
                    o[0] = fmaf(ALPHA, bflo(x0), gt[0] * (bflo(a0) + bflo(b0))); o[1] = fmaf(ALPHA, bfhi(x0), gt[1] * (bfhi(a0) + bfhi(b0)));
                    o[2] = fmaf(ALPHA, bflo(x1), gt[2] * (bflo(a1) + bflo(b1))); o[3] = fmaf(ALPHA, bfhi(x1), gt[3] * (bfhi(a1) + bfhi(b1)));
                    s += (o[0] + o[1]) + (o[2] + o[3]); }
            const float mean = wave_sum(s) * (1.f / DM); float s2 = 0.f;
#pragma unroll
            for (int k = 0; k < 4; ++k) { v[k] = v[k] - mean; s2 += (v[k][0] * v[k][0] + v[k][1] * v[k][1]) + (v[k][2] * v[k][2] + v[k][3] * v[k][3]); }
            const float rstd = 1.0f / sqrtf(wave_sum(s2) * (1.f / DM) + LN_EPS);
            f32x4 xn[4];
#pragma unroll
            for (int k = 0; k < 4; ++k) xn[k] = v[k] * rstd * lgv[k] + lbv[k];
            if (layer == 3) {
                if (rr >= NCTX) { float* xf = (xdummy ? xdummy + (size_t)row[r] * DM : P.out + (size_t)(b * SEQ + rr - NCTX) * DM) + 8 * lane;
#pragma unroll
                    for (int c = 0; c < 2; ++c) { __builtin_nontemporal_store(xn[2 * c], (f32x4*)(xf + 512 * c)); __builtin_nontemporal_store(xn[2 * c + 1], (f32x4*)(xf + 512 * c + 4)); } }
            } else {
                bf16* xd = (xdummy ? (bf16*)xdummy : X) + (size_t)row[r] * DM + 8 * lane; bf16* hd = H + (size_t)row[r] * DM + 8 * lane;
#pragma unroll
                for (int c = 0; c < 2; ++c) { v4u xo, ho;
#pragma unroll
                    for (int q = 0; q < 2; ++q) { const int col = 8 * lane + 512 * c + 4 * q; const f32x4 sh = *(const f32x4*)(modn + col), sc = *(const f32x4*)(modn + 1024 + col);
                        const f32x4 xx = xn[2 * c + q], hv = xx * sc + xx + sh;
                        xo[2 * q] = pk2(xx[0], xx[1]); xo[2 * q + 1] = pk2(xx[2], xx[3]); ho[2 * q] = pk2(hv[0], hv[1]); ho[2 * q + 1] = pk2(hv[2], hv[3]); }
                    __builtin_nontemporal_store(xo, (v4u*)(xd + 512 * c)); *(v4u*)(hd + 512 * c) = ho; }
            }
        }
    }
}

#ifndef PHSEL
#define PHSEL -1
#endif
#ifndef PROBE_GROUP
#define PROBE_GROUP 0
#endif
#define IN(k) ((PHSEL < 0 || PHSEL == (k)) && lo <= (k) && (k) < hi)
#define SEAM(k) do { if (IN(k) && IN((k) + 1)) { xcd_barrier(bar, HW_TID(wave0) == 0); if (PROBE_GROUP == 6) xcd_barrier(bar, HW_TID(wave0) == 0); } } while (0)
#define REP(g) for (int rep_ = 0; rep_ < ((PROBE_GROUP == (g)) ? 2 : 1); ++rep_)
#define LAUNDER() int tid = HW_TID(wave0); asm volatile("" : "+v"(tid)); const int lane = tid & 63, wave = __builtin_amdgcn_readfirstlane(tid >> 6); (void)lane; (void)wave
typedef pg8::EpiBf16<0> EpiPlain;
template <int LAYER>
__device__ __forceinline__ void run_layer(const Params& P, LAS unsigned char* lds, const XcdBarrier& bar, int lo, int hi, int wave0) {
    constexpr int pb = 2 + 9 * LAYER, kind = LAYER % 3, j = LAYER / 3;
    const int G = gridDim.x;
    if constexpr (kind == 0) {
        if (IN(pb + 0)) { LAUNDER(); if (LAYER > 0) REP(5) { moe_convert(P, LAYER, lds, blockIdx.x * NWAVES + wave, G * NWAVES, wave, lane); __syncthreads(); }
                          phase_s5v2<false>(P, j, lds, tid, wave, lane); __syncthreads(); SEAM(pb + 0); }
        if (IN(pb + 1)) { LAUNDER(); phase_s5_carry(P, j, lds, tid, wave, lane); SEAM(pb + 1); }
        if (IN(pb + 2)) { LAUNDER(); phase_s5v2<true>(P, j, lds, tid, wave, lane); __syncthreads(); SEAM(pb + 2); }
        if (IN(pb + 3)) { if (LAYER < 3) { LAUNDER(); ctx_gemm<true>((const bf16*)(P.ws + WS_QKV), (const bf16*)(P.ws + WS_WGLU) + (size_t)j * 2048 * DM, DM, (bf16*)(P.ws + WS_Y), DM, lds, wave, lane); }
                          pg8::Gemm g{(const bf16*)(P.ws + WS_QKV), (const bf16*)(P.ws + WS_WGLU) + (size_t)j * 2048 * DM, NR, 2048, DM, nullptr, 0}; pg8::LatOrder S; S.init(2048, G, (int)blockIdx.x);
                          pg8::EpiGlu E{(bf16*)(P.ws + WS_Y), DM}; REP(4) { pg8::gemm_phase<pg8::EpiGlu, pg8::LatOrder, true, true>(lds, g, S, E, HW_TID(wave0)); } SEAM(pb + 3); }
    } else if constexpr (kind == 1) {
        if (IN(pb + 0)) { { LAUNDER(); REP(5) { moe_convert(P, LAYER, lds, blockIdx.x * NWAVES + wave, G * NWAVES, wave, lane); __syncthreads(); } }
                          { LAUNDER(); ctx_gemm<false>((const bf16*)(P.ws + WS_H), (const bf16*)(P.ws + WS_WQKVB), QKV_B, (bf16*)(P.ws + WS_QKV), QKV_B, lds, wave, lane); }
                          pg8::Gemm g{(const bf16*)(P.ws + WS_H), (const bf16*)(P.ws + WS_WQKVB), NR, QKV_B, DM, nullptr, 0}; pg8::LatOrder S; S.init(QKV_B, G, (int)blockIdx.x);
                          pg8::EpiRopeB E{(bf16*)(P.ws + WS_QKV), QKV_B, (const float*)(P.ws + WS_ROPE), (const float*)(P.ws + WS_ROPE) + 4096, 1152}; REP(4) { pg8::gemm_phase<pg8::EpiRopeB, pg8::LatOrder, true, true>(lds, g, S, E, HW_TID(wave0)); } SEAM(pb + 0); }
        if (IN(pb + 2)) { REP(10) { phase_attn_swa(P, lds, wave0); } SEAM(pb + 2); }
        if (IN(pb + 3)) { { LAUNDER(); ctx_gemm<false>((const bf16*)(P.ws + WS_O), (const bf16*)(P.ws + WS_WOB), DM, (bf16*)(P.ws + WS_Y), DM, lds, wave, lane); }
                          pg8::Gemm g{(const bf16*)(P.ws + WS_O), (const bf16*)(P.ws + WS_WOB), NR, DM, DM, nullptr, 0}; pg8::LatOrder S; S.init(DM, G, (int)blockIdx.x);
                          EpiPlain E{(bf16*)(P.ws + WS_Y), DM, nullptr, 0, 0, 1.f}; REP(4) { pg8::gemm_phase<EpiPlain, pg8::LatOrder, true, true>(lds, g, S, E, HW_TID(wave0)); } SEAM(pb + 3); }
    } else {
        if (IN(pb + 0)) { { LAUNDER(); REP(5) { moe_convert(P, LAYER, lds, blockIdx.x * NWAVES + wave, G * NWAVES, wave, lane); __syncthreads(); } }
                          { LAUNDER(); ctx_gemm<false>((const bf16*)(P.ws + WS_H), (const bf16*)(P.ws + WS_WQKVC), QKV_C, (bf16*)(P.ws + WS_QKV), QKV_C, lds, wave, lane); }
                          pg8::Gemm g{(const bf16*)(P.ws + WS_H), (const bf16*)(P.ws + WS_WQKVC), NR, QKV_C, DM, nullptr, 0}; pg8::LatOrder S; S.init(QKV_C, G, (int)blockIdx.x);
                          EpiPlain E{(bf16*)(P.ws + WS_QKV), QKV_C, nullptr, 0, 0, 1.f}; REP(4) { pg8::gemm_phase<EpiPlain, pg8::LatOrder, true, true>(lds, g, S, E, HW_TID(wave0)); } SEAM(pb + 0); }
        if (IN(pb + 1)) { LAUNDER(); if (PROBE_GROUP == 9) phase_normrope_gqa(P, wave, lane, (bf16*)(P.ws + WS_END)); phase_normrope_gqa(P, wave, lane); phase_vt_gqa(P, lds, wave, lane); SEAM(pb + 1); }
        if (IN(pb + 2)) { REP(1) { phase_attn_gqa(P, lds, wave0); } SEAM(pb + 2); }
        if (IN(pb + 3)) { { LAUNDER(); ctx_gemm<false>((const bf16*)(P.ws + WS_O), (const bf16*)(P.ws + WS_WOC), DM, (bf16*)(P.ws + WS_Y), DM, lds, wave, lane); }
                          pg8::Gemm g{(const bf16*)(P.ws + WS_O), (const bf16*)(P.ws + WS_WOC), NR, DM, DM, nullptr, 0}; pg8::LatOrder S; S.init(DM, G, (int)blockIdx.x);
                          EpiPlain E{(bf16*)(P.ws + WS_Y), DM, nullptr, 0, 0, 1.f}; REP(4) { pg8::gemm_phase<EpiPlain, pg8::LatOrder, true, true>(lds, g, S, E, HW_TID(wave0)); } SEAM(pb + 3); }
    }
    if (IN(pb + 4)) { LAUNDER(); if (PROBE_GROUP == 7) { __syncthreads(); phase_ln1(P, LAYER, lds, tid, wave, lane, (float*)(P.ws + WS_END)); } __syncthreads(); phase_ln1(P, LAYER, lds, tid, wave, lane); SEAM(pb + 4); }
    if (IN(pb + 5)) { LAUNDER(); REP(12) { __syncthreads(); phase_dispatch(P, lds, tid, wave, lane); } SEAM(pb + 5); }
    if (IN(pb + 6)) { const int npan = ((const int*)(P.ws + WS_PANE))[0]; const int* pe = (const int*)(P.ws + WS_PANE) + 16;
                      pg8::Gemm g{(const bf16*)(P.ws + WS_H), (const bf16*)(P.ws + WS_WUP), npan * 256, DM, DM, pe, (size_t)DM * DM * 2, (const int*)(P.ws + WS_ROWMAP)}; pg8::StaticOrder S; S.init(npan * 256, DM, G, (int)blockIdx.x);
                      const int U = npan * 4, full = (U % G <= 64) ? (U / G) * G : U; S.lim = full;
                      pg8::EpiSwiglu E{(bf16*)(P.ws + WS_ACT), DEXP, (const float*)(P.ws + WS_GSLOT)}; REP(2) { pg8::gemm_phase<pg8::EpiSwiglu, pg8::StaticOrder, true, true, true>(lds, g, S, E, HW_TID(wave0)); }
                      pg8::gemm_tail<true>(lds, g, S, full, U, (bf16*)(P.ws + WS_ACT), DEXP, (const float*)(P.ws + WS_GSLOT), HW_TID(wave0)); SEAM(pb + 6); }
    if (IN(pb + 7)) { const int npan = ((const int*)(P.ws + WS_PANE))[0]; const int* pe = (const int*)(P.ws + WS_PANE) + 16;
                      pg8::Gemm g{(const bf16*)(P.ws + WS_ACT), (const bf16*)(P.ws + WS_WDN), npan * 256, DM, DEXP, pe, (size_t)DM * DEXP * 2}; pg8::StaticOrder S; S.init(npan * 256, DM, G, (int)blockIdx.x);
                      const int U = npan * 4, full = (U % G <= 64) ? (U / G) * G : U; S.lim = full;
                      EpiPlain E{(bf16*)(P.ws + WS_HS), DM, nullptr, 0, 0, 1.f}; REP(2) { pg8::gemm_phase<EpiPlain, pg8::StaticOrder, true, true>(lds, g, S, E, HW_TID(wave0)); }
                      pg8::gemm_tail<false>(lds, g, S, full, U, (bf16*)(P.ws + WS_HS), DM, nullptr, HW_TID(wave0)); SEAM(pb + 7); }
    if (IN(pb + 8)) { LAUNDER(); if (PROBE_GROUP == 8) phase_ln2(P, LAYER, wave, lane, (float*)(P.ws + WS_END)); phase_ln2(P, LAYER, wave, lane); if (LAYER < 3) SEAM(pb + 8); }
}
__global__ void __launch_bounds__(NTHREADS, 2) fwd_kernel(Params P) {
    extern __shared__ __attribute__((aligned(16))) unsigned char lds_raw[];
    LAS unsigned char* lds = (LAS unsigned char*)lds_raw;
    unsigned* ctl = (unsigned*)(P.ws + WS_CTL);
    const int wave0 = __builtin_amdgcn_readfirstlane((int)threadIdx.x >> 6);
    for (int u = threadIdx.x; u < (LDS_BYTES - LDSCTL_OFF) / 4; u += NTHREADS) ((LAS unsigned*)(lds + LDSCTL_OFF))[u] = 0u;
    __syncthreads();
    XcdBarrier bar = xcd_barrier_post(ctl + CW_BAR, (volatile LAS unsigned*)(lds + MISC_OFF) + 8);
    const int lo = P.ph_lo, hi = P.ph_hi;
    if (IN(0)) { LAUNDER(); REP(11) { phase_prologue(P, lds, tid, wave, lane); __syncthreads(); } SEAM(0); }
    if (IN(1)) { LAUNDER(); REP(5) { phase_h0(P, wave, lane); } phase_s5_tables(P, tid); SEAM(1); }
    run_layer<0>(P, lds, bar, lo, hi, wave0);
    run_layer<1>(P, lds, bar, lo, hi, wave0);
    run_layer<2>(P, lds, bar, lo, hi, wave0);
    run_layer<3>(P, lds, bar, lo, hi, wave0);
}
#undef LAUNDER
#undef REP
#undef IN
#undef SEAM

extern "C" void kernel_launch(void* const* d_in, const int* in_sizes, int n_in, void* d_out, int out_size, void* d_ws, size_t ws_size, hipStream_t stream) {
    static int ok = 0;
    if (ok == 0) {
        if (n_in != 30 || in_sizes[0] != NBATCH * SEQ * DM || out_size != NBATCH * SEQ * DM || ws_size < WS_END + (PROBE_GROUP >= 7 ? 140 * MiB : 0)) {
            fprintf(stderr, "kernel_launch: shape mismatch: n_in %d in0 %d out %d ws %zu (need %zu)\n", n_in, n_in > 0 ? in_sizes[0] : -1, out_size, ws_size, (size_t)WS_END); ok = -1; return; }
        if (hipFuncSetAttribute((const void*)fwd_kernel, hipFuncAttributeMaxDynamicSharedMemorySize, LDS_BYTES) != hipSuccess) { fprintf(stderr, "kernel_launch: hipFuncSetAttribute failed\n"); ok = -1; return; }
        int dev = 0, cus = 0, per_cu = 0;
        (void)hipGetDevice(&dev); (void)hipDeviceGetAttribute(&cus, hipDeviceAttributeMultiprocessorCount, dev);
        if (hipOccupancyMaxActiveBlocksPerMultiprocessor(&per_cu, (const void*)fwd_kernel, NTHREADS, LDS_BYTES) != hipSuccess || per_cu < 1 || cus < NGRID)
            fprintf(stderr, "kernel_launch: note: occupancy query says %d blocks per CU on %d CUs; this kernel needs %d resident blocks\n", per_cu, cus, NGRID);
        (void)hipGetLastError();
        ok = 1;
    }
    if (ok < 0) return;
    if (hipMemsetAsync((char*)d_ws + WS_CTL, 0, CTL_ZERO_BYTES, stream) != hipSuccess) { fprintf(stderr, "kernel_launch: memset failed\n"); return; }
    Params p{};
    for (int i = 0; i < 30; ++i) p.in[i] = (const float*)d_in[i];
    p.out = (float*)d_out; p.ws = (unsigned char*)d_ws;
#if MK_MULTI
    for (int ph = 0; ph < NPHASE; ++ph) { p.ph_lo = ph; p.ph_hi = ph + 1; hipLaunchKernelGGL(fwd_kernel, dim3(NGRID), dim3(NTHREADS), LDS_BYTES, stream, p); }
#else
    p.ph_lo = 0; p.ph_hi = NPHASE;
    hipLaunchKernelGGL(fwd_kernel, dim3(NGRID), dim3(NTHREADS), LDS_BYTES, stream, p);
#endif
    const hipError_t le = hipPeekAtLastError();
    if (le != hipSuccess) fprintf(stderr, "kernel_launch: launch failed: %s\n", hipGetErrorName(le));
}
```

```cpp
#include <hip/hip_runtime.h>
#include <cstdio>
#include <cstdint>
__device__ __forceinline__ int hw_lane() { int l; asm volatile("v_mbcnt_lo_u32_b32 %0, -1, 0\n\tv_mbcnt_hi_u32_b32 %0, -1, %0" : "=v"(l)); return l; }
#define HW_TID(w0) ((w0) * 64 + hw_lane())
namespace pg8 {
#define PG8_LAS __attribute__((address_space(3)))
typedef unsigned short bf16_t;
typedef short bf16x8 __attribute__((ext_vector_type(8)));
typedef float f32x4 __attribute__((ext_vector_type(4)));
typedef unsigned u32x4 __attribute__((ext_vector_type(4)));
constexpr int BM = 256, BK = 64, HALF = 128, HTB = HALF * BK * 2  , STAGE_BYTES = 8 * HTB, NXCD = 8, WGM = 8;

__host__ __device__ __forceinline__ int lds_byte(int r, int c) { const int st = (r >> 4) * 2 + (c >> 5), rr = r & 15, cc = c & 31, ob = rr * 64 + cc * 2; return st * 1024 + (ob ^ (((ob >> 9) & 1) << 5)); }
__host__ __device__ __forceinline__ void stage_rc(int b, int& R, int& C) { const int st = b / 1024, sb = b % 1024, swz = sb ^ (((sb >> 9) & 1) << 5); R = (st >> 1) * 16 + swz / 64; C = (st & 1) * 32 + (swz % 64) / 2; }
__host__ __device__ __forceinline__ int perm32(int rho) { const int n = rho >> 4, i = rho & 15; return 8 * (i >> 2) + 4 * n + (i & 3); }

struct Unit { int pm, pn; };
struct Gemm { const bf16_t* A; const bf16_t* Bt; int M, N, K; const int* pe; size_t bstride; const int* rowmap; };

struct StaticOrder {
    int nM, nN, nwg, G, c, lim;
    __host__ __device__ void init(int M, int N, int G_, int c_) { nM = M / BM; nN = N / BM; nwg = nM * nN; G = G_; c = c_; lim = nwg; }
    __host__ __device__ void at(int L, Unit& u) const {
        int wgid = L; { const int q = nwg / NXCD, r = nwg % NXCD, xcd = wgid % NXCD, off = wgid / NXCD; wgid = (xcd < r ? xcd * (q + 1) : r * (q + 1) + (xcd - r) * q) + off; }
        const int nig = WGM * nN, gid = wgid / nig, fm = gid * WGM, gsz = (nM - fm) < WGM ? (nM - fm) : WGM;
        u.pm = fm + ((wgid % nig) % gsz); u.pn = (wgid % nig) / gsz;
    }
    __host__ __device__ bool next(int i, Unit& u) const {
        const long L = (long)i * G + c; if (L >= lim) return false;
        at((int)L, u); return true;
    }
    __device__ __forceinline__ void a_ready(const Unit&) const {}
    __device__ __forceinline__ void done(const Unit&) const {}
};

struct LatOrder {
    StaticOrder S;
    __host__ __device__ void init(int N, int G_, int c_) { S.init(128 * BM, N, G_, c_); }
    __host__ __device__ bool next(int i, Unit& u) const { if (!S.next(i, u)) return false; u.pm = u.pm + 1 + (u.pm >> 6); return true; }
    __device__ __forceinline__ void a_ready(const Unit&) const {}
    __device__ __forceinline__ void done(const Unit&) const {}
};

__device__ __forceinline__ unsigned cvt_pk_bf16(float lo, float hi) { unsigned r; asm volatile("v_cvt_pk_bf16_f32 %0, %1, %2" : "=v"(r) : "v"(lo), "v"(hi)); return r; }
typedef float f32x2 __attribute__((ext_vector_type(2)));
__device__ __forceinline__ f32x2 gelu_pk(f32x2 v) {
    const f32x2 av = __builtin_elementwise_abs(v), d = av * 0.2316418882f + 1.0f;
    f32x2 t; t.x = __builtin_amdgcn_rcpf(d.x); t.y = __builtin_amdgcn_rcpf(d.y);
    f32x2 q = t * 0.5307027145f + (-0.7265760135f); q = q * t + 0.7107068705f; q = q * t + (-0.142248368f); q = q * t + 0.127414796f; q = q * t;
    const f32x2 s = (v * v) * (-0.72134752044f);
    f32x2 e; e.x = __builtin_amdgcn_exp2f(s.x); e.y = __builtin_amdgcn_exp2f(s.y);
    const f32x2 m = v * (q * e), r = v - m;
    f32x2 o; o.x = v.x < 0.f ? m.x : r.x; o.y = v.y < 0.f ? m.y : r.y; return o;
}

template <int ACT  > struct EpiBf16 {
    static constexpr bool PERM = true, AFTER_DRAIN = false; static_assert(ACT == 0 || ACT == 1, "EpiBf16: ACT is 0 (none) or 1 (gelu_pk)");
    bf16_t* O; int ldc; const float* bias; int split_cols; size_t split_stride; float scale0;
    __device__ __forceinline__ void operator()(const f32x4 (&acc)[2][2][4][2], const Unit& u, int wr, int wc, int fr, int fq) const {
        const int row0 = u.pm * BM + wr * 64 + fr; int colt = u.pn * BM; bf16_t* base = O;
        float sc = 1.f; if (split_cols) { const int t = colt / split_cols; base += (size_t)t * split_stride; colt -= t * split_cols; if (t == 0) sc = scale0; }
        const int col0 = colt + wc * 32 + 8 * fq, bcol0 = u.pn * BM + wc * 32 + 8 * fq;
        f32x4 bv[2][2];
#pragma unroll
        for (int bj = 0; bj < 2; ++bj)
#pragma unroll
            for (int n = 0; n < 2; ++n) bv[bj][n] = bias ? *(const f32x4*)(bias + bcol0 + bj * HALF + 4 * n) : (f32x4){0.f, 0.f, 0.f, 0.f};
#pragma unroll
        for (int ai = 0; ai < 2; ++ai)
#pragma unroll
            for (int m = 0; m < 4; ++m) { bf16_t* rowp = base + (size_t)(row0 + ai * HALF + m * 16) * ldc + col0;
#pragma unroll
                for (int bj = 0; bj < 2; ++bj) { f32x4 v0 = acc[ai][bj][m][0] + bv[bj][0], v1 = acc[ai][bj][m][1] + bv[bj][1];
                    if (ACT == 1) { f32x2 a = gelu_pk((f32x2){v0[0], v0[1]}), b = gelu_pk((f32x2){v0[2], v0[3]}), c = gelu_pk((f32x2){v1[0], v1[1]}), d = gelu_pk((f32x2){v1[2], v1[3]});
                        v0 = (f32x4){a.x, a.y, b.x, b.y}; v1 = (f32x4){c.x, c.y, d.x, d.y}; }
                    v0 = v0 * sc; v1 = v1 * sc; u32x4 w; w.x = cvt_pk_bf16(v0[0], v0[1]); w.y = cvt_pk_bf16(v0[2], v0[3]); w.z = cvt_pk_bf16(v1[0], v1[1]); w.w = cvt_pk_bf16(v1[2], v1[3]);
                    *(u32x4*)(rowp + bj * HALF) = w; } }
    }
};


__device__ __forceinline__ float sigmoidf_fast(float x) { return __builtin_amdgcn_rcpf(1.0f + __builtin_amdgcn_exp2f(-1.4426950408889634f * x)); }
struct EpiGlu {
    static constexpr bool PERM = true, AFTER_DRAIN = false;
    bf16_t* O; int ldc;
    __device__ __forceinline__ void operator()(const f32x4 (&acc)[2][2][4][2], const Unit& u, int wr, int wc, int fr, int fq) const {
        const int row0 = u.pm * BM + wr * 64 + fr, col0 = u.pn * HALF + wc * 32 + 8 * fq;
#pragma unroll
        for (int ai = 0; ai < 2; ++ai)
#pragma unroll
            for (int m = 0; m < 4; ++m) { bf16_t* rowp = O + (size_t)(row0 + ai * HALF + m * 16) * ldc + col0;
                float o[8];
#pragma unroll
                for (int n = 0; n < 2; ++n)
#pragma unroll
                    for (int j = 0; j < 4; ++j) o[4 * n + j] = acc[ai][0][m][n][j] * sigmoidf_fast(acc[ai][1][m][n][j]);
                u32x4 w; w.x = cvt_pk_bf16(o[0], o[1]); w.y = cvt_pk_bf16(o[2], o[3]); w.z = cvt_pk_bf16(o[4], o[5]); w.w = cvt_pk_bf16(o[6], o[7]);
                *(u32x4*)rowp = w; }
    }
};
struct EpiRopeB {
    static constexpr bool PERM = true, AFTER_DRAIN = false;
    bf16_t* O; int ldc; const float* cosT; const float* sinT; int rope_cols;
    __device__ __forceinline__ void operator()(const f32x4 (&acc)[2][2][4][2], const Unit& u, int wr, int wc, int fr, int fq) const {
        const int row0 = u.pm * BM + wr * 64 + fr, col0 = u.pn * BM + wc * 32 + 8 * fq;
        const int pbk = u.pm % 65, t0 = (pbk - 1) * BM + wr * 64 + fr;
        const int i0 = 8 * (fq & 1); const bool second = fq >= 2;
#pragma unroll
        for (int ai = 0; ai < 2; ++ai)
#pragma unroll
            for (int m = 0; m < 4; ++m) { const int t = t0 + ai * HALF + m * 16, pos = (wc & 1) ? (t & 63) : (t >> 6);
                const f32x4 c0 = *(const f32x4*)(cosT + pos * 16 + i0), c1 = *(const f32x4*)(cosT + pos * 16 + i0 + 4), s0 = *(const f32x4*)(sinT + pos * 16 + i0), s1 = *(const f32x4*)(sinT + pos * 16 + i0 + 4);
                bf16_t* rowp = O + (size_t)(row0 + ai * HALF + m * 16) * ldc + col0;
#pragma unroll
                for (int bj = 0; bj < 2; ++bj) { f32x4 v0 = acc[ai][bj][m][0], v1 = acc[ai][bj][m][1];
                    if (u.pn * BM + bj * HALF < rope_cols) {
                        f32x4 p0, p1;
#pragma unroll
                        for (int j = 0; j < 4; ++j) { p0[j] = __shfl_xor(v0[j], 32); p1[j] = __shfl_xor(v1[j], 32); }
                        v0 = second ? v0 * c0 + p0 * s0 : v0 * c0 - p0 * s0; v1 = second ? v1 * c1 + p1 * s1 : v1 * c1 - p1 * s1; }
                    u32x4 w; w.x = cvt_pk_bf16(v0[0], v0[1]); w.y = cvt_pk_bf16(v0[2], v0[3]); w.z = cvt_pk_bf16(v1[0], v1[1]); w.w = cvt_pk_bf16(v1[2], v1[3]);
                    *(u32x4*)(rowp + bj * HALF) = w; } }
    }
};
struct EpiSwiglu {
    static constexpr bool PERM = true, AFTER_DRAIN = false;
    bf16_t* O; int ldc; const float* gate;
    __device__ __forceinline__ void operator()(const f32x4 (&acc)[2][2][4][2], const Unit& u, int wr, int wc, int fr, int fq) const {
        const int row0 = u.pm * BM + wr * 64 + fr, col0 = u.pn * HALF + wc * 32 + 8 * fq;
        float gwv[2][4];
#pragma unroll
        for (int ai = 0; ai < 2; ++ai)
#pragma unroll
            for (int m = 0; m < 4; ++m) gwv[ai][m] = gate[row0 + ai * HALF + m * 16];
#pragma unroll
        for (int ai = 0; ai < 2; ++ai)
#pragma unroll
            for (int m = 0; m < 4; ++m) { const int row = row0 + ai * HALF + m * 16; bf16_t* rowp = O + (size_t)row * ldc + col0; const float gw = gwv[ai][m];
                float o[8];
#pragma unroll
                for (int n = 0; n < 2; ++n)
#pragma unroll
                    for (int j = 0; j < 4; ++j) { const float a1 = acc[ai][0][m][n][j]; o[4 * n + j] = a1 * sigmoidf_fast(a1) * acc[ai][1][m][n][j] * gw; }
                u32x4 w; w.x = cvt_pk_bf16(o[0], o[1]); w.y = cvt_pk_bf16(o[2], o[3]); w.z = cvt_pk_bf16(o[4], o[5]); w.w = cvt_pk_bf16(o[6], o[7]);
                *(u32x4*)rowp = w; }
    }
};
template <class Epi, class Sched, bool ALIGN_EPI = false, bool SP2 = false, bool GATHER = false>
__device__ __forceinline__ void gemm_phase(PG8_LAS unsigned char* lds, const Gemm g, const Sched& S, const Epi& E, int tid_in) {
    int tid_l = tid_in; asm volatile("" : "+v"(tid_l));
    const int tid = tid_l, wid = __builtin_amdgcn_readfirstlane(tid >> 6), lane = tid & 63, wr = wid >> 2, wc = wid & 3, fr = lane & 15, fq = lane >> 4;
    const int K = g.K, nt = K / BK;
    unsigned voffA[2], voffB[2];
#pragma unroll
    for (int i = 0; i < 2; ++i) { int R, C; stage_rc(tid * 16 + i * 8192, R, C); const int Rb = Epi::PERM ? ((R & ~31) + perm32(R & 31)) : R;
        voffA[i] = (unsigned)(R * K + C) * 2u; voffB[i] = (unsigned)(Rb * K + C) * 2u; }
    static_assert(!GATHER || SP2, "GATHER is wired into the SP2 loop only");
    int gR[2], gC[2]; unsigned voffAc[2][2], voffAn[2][2];
#pragma unroll
    for (int i = 0; i < 2; ++i) { int R, C; stage_rc(tid * 16 + i * 8192, R, C); gR[i] = R; gC[i] = C * 2; }
#define PG8_GVOFF(dst, pm_) do { if constexpr (GATHER) { _Pragma("unroll") for (int hh_ = 0; hh_ < 2; ++hh_) _Pragma("unroll") for (int i_ = 0; i_ < 2; ++i_) \
        dst[hh_][i_] = (unsigned)g.rowmap[(pm_) * BM + hh_ * HALF + gR[i_]] * (unsigned)(K * 2) + (unsigned)gC[i_]; } } while (0)
#define PG8_STAGE_A(bufoff, gbase, hh, nf) do { if constexpr (GATHER) { const unsigned o0_ = (nf) ? voffAn[hh][0] : voffAc[hh][0], o1_ = (nf) ? voffAn[hh][1] : voffAc[hh][1]; \
        __builtin_amdgcn_global_load_lds((const unsigned*)((const char*)(gbase) + o0_), (PG8_LAS unsigned*)(lds + (bufoff) + ldsw), 16, 0, 0); \
        __builtin_amdgcn_global_load_lds((const unsigned*)((const char*)(gbase) + o1_), (PG8_LAS unsigned*)(lds + (bufoff) + ldsw + 8192), 16, 0, 0); } \
      else { PG8_STAGE(bufoff, (gbase) + (hh) * hstep, voffA); } } while (0)
    const size_t kstep = (size_t)(BK * 2);
    const size_t hstep = (size_t)HALF * K * 2;
    const size_t tstep = 2 * hstep;
    const unsigned ldsw = (unsigned)wid * 1024u;
    const int aoff = lds_byte(wr * 64 + fr, fq * 8), boff = lds_byte(wc * 32 + fr, fq * 8);
#define PG8_SA(b, h) (((b) * 2 + (h)) * HTB)
#define PG8_SB(b, h) ((4 + (b) * 2 + (h)) * HTB)
#define PG8_STAGE(bufoff, gbase, voff) do { _Pragma("unroll") for (int _i = 0; _i < 2; ++_i) \
        __builtin_amdgcn_global_load_lds((const unsigned*)((const char*)(gbase) + (voff)[_i]), (PG8_LAS unsigned*)(lds + (bufoff) + ldsw + _i * 8192), 16, 0, 0); } while (0)
#define PG8_LDA(dst, b, h) do { _Pragma("unroll") for (int m = 0; m < 4; ++m) _Pragma("unroll") for (int k = 0; k < 2; ++k) dst[m][k] = *(const PG8_LAS bf16x8*)(lds + PG8_SA(b, h) + aoff + m * 2048 + k * 1024); } while (0)
#define PG8_LDB(dst, b, h) do { _Pragma("unroll") for (int n = 0; n < 2; ++n) _Pragma("unroll") for (int k = 0; k < 2; ++k) dst[n][k] = *(const PG8_LAS bf16x8*)(lds + PG8_SB(b, h) + boff + n * 2048 + k * 1024); } while (0)
#define PG8_MMA(ai, bj, At, Bt) do { __builtin_amdgcn_s_setprio(1); _Pragma("unroll") for (int m = 0; m < 4; ++m) _Pragma("unroll") for (int n = 0; n < 2; ++n) _Pragma("unroll") for (int k = 0; k < 2; ++k) \
        acc[ai][bj][m][n] = __builtin_amdgcn_mfma_f32_16x16x32_bf16(Bt[n][k], At[m][k], acc[ai][bj][m][n], 0, 0, 0); __builtin_amdgcn_s_setprio(0); } while (0)
#define PG8_WAIT_V(n) asm volatile("s_waitcnt vmcnt(" #n ")" ::: "memory")
#define PG8_WAIT_L(n) asm volatile("s_waitcnt lgkmcnt(" #n ")" ::: "memory")
#define PG8_BAR __builtin_amdgcn_s_barrier()
#define PG8_SCHED __builtin_amdgcn_sched_barrier(0)
    Unit cur, nxt; int ui = 0;
    if (!S.next(0, cur)) return;
    f32x4 acc[2][2][4][2];
#pragma unroll
    for (int a = 0; a < 2; ++a)
#pragma unroll
        for (int b = 0; b < 2; ++b)
#pragma unroll
            for (int m = 0; m < 4; ++m)
#pragma unroll
                for (int n = 0; n < 2; ++n) acc[a][b][m][n] = (f32x4){0.f, 0.f, 0.f, 0.f};
    bf16x8 At[4][2], B0[2][2], B1[2][2];
    const char* cA = GATHER ? (const char*)g.A : (const char*)g.A + (size_t)cur.pm * tstep; PG8_GVOFF(voffAc, cur.pm); const char* cB = (const char*)g.Bt + (size_t)cur.pn * tstep + (g.pe ? (size_t)g.pe[cur.pm] * g.bstride : (size_t)0);
    S.a_ready(cur);
    if constexpr (SP2) {
        PG8_STAGE(PG8_SB(0, 0), cB, voffB); PG8_STAGE(PG8_SB(0, 1), cB + hstep, voffB); PG8_STAGE_A(PG8_SA(0, 0), cA, 0, false); PG8_STAGE_A(PG8_SA(0, 1), cA, 1, false);
        if (wr == 1) PG8_BAR;
        PG8_WAIT_V(2); PG8_BAR;
        PG8_STAGE(PG8_SB(1, 0), cB + kstep, voffB); PG8_STAGE_A(PG8_SA(1, 0), cA + kstep, 0, false); PG8_STAGE(PG8_SB(1, 1), cB + hstep + kstep, voffB);
        PG8_WAIT_V(6); PG8_BAR;
    } else {
        PG8_STAGE(PG8_SB(0, 0), cB, voffB); PG8_STAGE(PG8_SA(0, 0), cA, voffA); PG8_STAGE(PG8_SB(0, 1), cB + hstep, voffB); PG8_STAGE(PG8_SA(0, 1), cA + hstep, voffA);
        if (wr == 1) PG8_BAR;
        PG8_WAIT_V(4); PG8_BAR;
        PG8_STAGE(PG8_SB(1, 0), cB + kstep, voffB); PG8_STAGE(PG8_SA(1, 0), cA + kstep, voffA); PG8_STAGE(PG8_SB(1, 1), cB + hstep + kstep, voffB);
        PG8_WAIT_V(6); PG8_BAR;
    }
    for (;;) {
        const bool has_next = S.next(ui + 1, nxt);
        const char* nA = GATHER ? cA : (has_next ? (const char*)g.A + (size_t)nxt.pm * tstep : cA);
        if constexpr (GATHER) { if (has_next) PG8_GVOFF(voffAn, nxt.pm); else { _Pragma("unroll") for (int hh_ = 0; hh_ < 2; ++hh_) _Pragma("unroll") for (int i_ = 0; i_ < 2; ++i_) voffAn[hh_][i_] = voffAc[hh_][i_]; } } const char* nB = has_next ? (const char*)g.Bt + (size_t)nxt.pn * tstep + (g.pe ? (size_t)g.pe[nxt.pm] * g.bstride : (size_t)0) : cB;
        for (int t = 0; t < nt; t += 2) {
            const bool last = (t == nt - 2);
            const char* a1 = cA + (size_t)(t + 1) * kstep;
            const char* a2 = last ? nA : cA + (size_t)(t + 2) * kstep; const char* b2 = last ? nB : cB + (size_t)(t + 2) * kstep;
            const char* a3 = a2 + kstep; const char* b3 = b2 + kstep;
            if (last && has_next) S.a_ready(nxt);
            if constexpr (SP2) {
            PG8_LDB(B0, 0, 0); PG8_LDB(B1, 0, 1); PG8_SCHED; PG8_LDA(At, 0, 0); PG8_STAGE_A(PG8_SA(1, 1), a1, 1, false);
            PG8_WAIT_V(8); PG8_WAIT_L(0); PG8_BAR; PG8_MMA(0, 0, At, B0); PG8_MMA(0, 1, At, B1); PG8_BAR; PG8_SCHED;
            PG8_LDA(At, 0, 1); PG8_STAGE(PG8_SB(0, 0), b2, voffB); PG8_STAGE(PG8_SB(0, 1), b2 + hstep, voffB); PG8_STAGE_A(PG8_SA(0, 0), a2, 0, last);
            PG8_WAIT_V(8); PG8_WAIT_L(0); PG8_BAR; PG8_MMA(1, 0, At, B0); PG8_MMA(1, 1, At, B1); PG8_BAR; PG8_SCHED;
            PG8_LDB(B0, 1, 0); PG8_LDB(B1, 1, 1); PG8_SCHED; PG8_LDA(At, 1, 0); PG8_STAGE_A(PG8_SA(0, 1), a2, 1, last);
            PG8_WAIT_V(8); PG8_WAIT_L(0); PG8_BAR; PG8_MMA(0, 0, At, B0); PG8_MMA(0, 1, At, B1); PG8_BAR; PG8_SCHED;
            PG8_LDA(At, 1, 1); PG8_STAGE(PG8_SB(1, 0), b3, voffB); PG8_STAGE(PG8_SB(1, 1), b3 + hstep, voffB); PG8_STAGE_A(PG8_SA(1, 0), a3, 0, last);
            PG8_WAIT_V(8); PG8_WAIT_L(0); PG8_BAR; PG8_MMA(1, 0, At, B0); PG8_MMA(1, 1, At, B1); PG8_BAR; PG8_SCHED;
            } else {
            PG8_LDB(B0, 0, 0); PG8_SCHED; PG8_LDA(At, 0, 0); PG8_STAGE(PG8_SA(1, 1), a1 + hstep, voffA);
            PG8_WAIT_L(8); PG8_BAR; PG8_WAIT_L(0); PG8_MMA(0, 0, At, B0); PG8_BAR; PG8_SCHED;
            PG8_LDB(B1, 0, 1); PG8_STAGE(PG8_SB(0, 0), b2, voffB);
            PG8_BAR; PG8_WAIT_L(0); PG8_MMA(0, 1, At, B1); PG8_BAR;
            PG8_LDA(At, 0, 1); PG8_STAGE(PG8_SA(0, 0), a2, voffA);
            PG8_BAR; PG8_WAIT_L(0); PG8_MMA(1, 0, At, B0); PG8_BAR; PG8_SCHED;
            PG8_STAGE(PG8_SB(0, 1), b2 + hstep, voffB);
            PG8_WAIT_V(6); PG8_BAR; PG8_MMA(1, 1, At, B1); PG8_BAR;
            PG8_LDB(B0, 1, 0); PG8_SCHED; PG8_LDA(At, 1, 0); PG8_STAGE(PG8_SA(0, 1), a2 + hstep, voffA);
            PG8_WAIT_L(8); PG8_BAR; PG8_WAIT_L(0); PG8_MMA(0, 0, At, B0); PG8_BAR; PG8_SCHED;
            PG8_LDB(B1, 1, 1); PG8_STAGE(PG8_SB(1, 0), b3, voffB);
            PG8_BAR; PG8_WAIT_L(0); PG8_MMA(0, 1, At, B1); PG8_BAR;
            PG8_LDA(At, 1, 1); PG8_STAGE(PG8_SA(1, 0), a3, voffA);
            PG8_BAR; PG8_WAIT_L(0); PG8_MMA(1, 0, At, B0); PG8_BAR; PG8_SCHED;
            PG8_STAGE(PG8_SB(1, 1), b3 + hstep, voffB);
            PG8_WAIT_V(6); PG8_BAR; PG8_MMA(1, 1, At, B1); PG8_BAR;
            }
        }
        if constexpr (ALIGN_EPI) { if (wr == 0) PG8_BAR; }
        if constexpr (!Epi::AFTER_DRAIN) { E(acc, cur, wr, wc, fr, fq); S.done(cur); }
        if (!has_next) break;
#pragma unroll
        for (int a = 0; a < 2; ++a)
#pragma unroll
            for (int b = 0; b < 2; ++b)
#pragma unroll
                for (int m = 0; m < 4; ++m)
#pragma unroll
                    for (int n = 0; n < 2; ++n) acc[a][b][m][n] = (f32x4){0.f, 0.f, 0.f, 0.f};
        cur = nxt; cA = nA; cB = nB; ++ui;
        if constexpr (GATHER) { _Pragma("unroll") for (int hh_ = 0; hh_ < 2; ++hh_) _Pragma("unroll") for (int i_ = 0; i_ < 2; ++i_) voffAc[hh_][i_] = voffAn[hh_][i_]; }
        if constexpr (ALIGN_EPI) { if (wr == 1) PG8_BAR; }
    }
    PG8_WAIT_V(0);
    if constexpr (!ALIGN_EPI) { if (wr == 0) PG8_BAR; }
    PG8_BAR;
    if constexpr (Epi::AFTER_DRAIN) { E.fused(acc, cur, wr, wc, fr, fq, lds, wid, lane); S.done(cur); }
#undef PG8_SA
#undef PG8_SB
#undef PG8_STAGE
#undef PG8_STAGE_A
#undef PG8_GVOFF
#undef PG8_LDA
#undef PG8_LDB
#undef PG8_MMA
#undef PG8_WAIT_V
#undef PG8_WAIT_L
#undef PG8_BAR
#undef PG8_SCHED
}
template <bool UP>
__device__ __forceinline__ void gemm_quarter(PG8_LAS unsigned char* lds, const Gemm g, const Unit u, int ah, int bh, bf16_t* O, int ldc, const float* gate, int tid_in) {
    int tid_l = tid_in; asm volatile("" : "+v"(tid_l));
    const int tid = tid_l, wid = __builtin_amdgcn_readfirstlane(tid >> 6), lane = tid & 63, wr = wid >> 2, wc = wid & 3, fr = lane & 15, fq = lane >> 4;
    const int K = g.K, nt = K / BK;
    unsigned offA[2], offB[2];
#pragma unroll
    for (int i = 0; i < 2; ++i) { int R, C; stage_rc(tid * 16 + i * 8192, R, C);
        const int ra = u.pm * BM + ah * HALF + R; const unsigned arow = UP ? (unsigned)g.rowmap[ra] : (unsigned)ra;
        const int rb = UP ? (u.pn * BM + ((R >> 4) & 1) * HALF + bh * 64 + (R >> 5) * 16 + (R & 15)) : (u.pn * BM + bh * HALF + R);
        offA[i] = (arow * (unsigned)K + (unsigned)C) * 2u; offB[i] = ((unsigned)rb * (unsigned)K + (unsigned)C) * 2u; }
    const char* Ab = (const char*)g.A; const char* Bb = (const char*)g.Bt + (g.pe ? (size_t)g.pe[u.pm] * g.bstride : (size_t)0);
    const unsigned ldsw = (unsigned)wid * 1024u;
    const int aoff = lds_byte(wr * 64 + fr, fq * 8), boff = lds_byte(wc * 32 + fr, fq * 8);
#define PQ_STAGE(kt, slot) do { const unsigned so_ = (unsigned)(slot) * (unsigned)(2 * HTB); const size_t ko_ = (size_t)(kt) * (size_t)(BK * 2); _Pragma("unroll") for (int i_ = 0; i_ < 2; ++i_) { \
        __builtin_amdgcn_global_load_lds((const unsigned*)(Ab + offA[i_] + ko_), (PG8_LAS unsigned*)(lds + so_ + ldsw + i_ * 8192), 16, 0, 0); \
        __builtin_amdgcn_global_load_lds((const unsigned*)(Bb + offB[i_] + ko_), (PG8_LAS unsigned*)(lds + so_ + HTB + ldsw + i_ * 8192), 16, 0, 0); } } while (0)
    f32x4 acc[4][2];
#pragma unroll
    for (int m = 0; m < 4; ++m)
#pragma unroll
        for (int n = 0; n < 2; ++n) acc[m][n] = (f32x4){0.f, 0.f, 0.f, 0.f};
    PQ_STAGE(0, 0); PQ_STAGE(1, 1); PQ_STAGE(2, 2);
    bf16x8 At[2][4][2], Bq[2][2][2];
#define PQ_READ(set, slot) do { _Pragma("unroll") for (int n = 0; n < 2; ++n) _Pragma("unroll") for (int k = 0; k < 2; ++k) Bq[set][n][k] = *(const PG8_LAS bf16x8*)(lds + (slot) * (2 * HTB) + HTB + boff + n * 2048 + k * 1024); \
        _Pragma("unroll") for (int m = 0; m < 4; ++m) _Pragma("unroll") for (int k = 0; k < 2; ++k) At[set][m][k] = *(const PG8_LAS bf16x8*)(lds + (slot) * (2 * HTB) + aoff + m * 2048 + k * 1024); } while (0)
    asm volatile("s_waitcnt vmcnt(8)" ::: "memory"); __builtin_amdgcn_s_barrier(); __builtin_amdgcn_sched_barrier(0);
    PQ_READ(0, 0); __builtin_amdgcn_sched_barrier(0);
    for (int t4 = 0; t4 < nt; t4 += 4) {
#pragma unroll
        for (int s = 0; s < 4; ++s) { const int t = t4 + s;
            asm volatile("s_waitcnt vmcnt(4)" ::: "memory"); asm volatile("s_waitcnt lgkmcnt(0)" ::: "memory"); __builtin_amdgcn_s_barrier(); __builtin_amdgcn_sched_barrier(0);
            { const int tn = (t + 3 < nt) ? t + 3 : nt - 1; PQ_STAGE(tn, (s + 3) & 3); }
            PQ_READ((s + 1) & 1, (s + 1) & 3);
            __builtin_amdgcn_sched_barrier(0);
#pragma unroll
            for (int k = 0; k < 2; ++k)
#pragma unroll
                for (int m = 0; m < 4; ++m)
#pragma unroll
                    for (int n = 0; n < 2; ++n) acc[m][n] = __builtin_amdgcn_mfma_f32_16x16x32_bf16(Bq[s & 1][n][k], At[s & 1][m][k], acc[m][n], 0, 0, 0);
            __builtin_amdgcn_sched_barrier(0);
        }
    }
#undef PQ_READ
#undef PQ_STAGE
    const int row0 = u.pm * BM + ah * HALF + wr * 64 + fr;
    if constexpr (UP) {
        const int col0 = u.pn * HALF + bh * 64 + wc * 16 + 4 * fq;
#pragma unroll
        for (int m = 0; m < 4; ++m) { const int row = row0 + m * 16; const float gw = gate[row]; float o[4];
#pragma unroll
            for (int j = 0; j < 4; ++j) { const float a1 = acc[m][0][j]; o[j] = a1 * sigmoidf_fast(a1) * acc[m][1][j] * gw; }
            uint2 w; w.x = cvt_pk_bf16(o[0], o[1]); w.y = cvt_pk_bf16(o[2], o[3]); *(uint2*)(O + (size_t)row * ldc + col0) = w; }
    } else {
        const int col0 = u.pn * BM + bh * HALF + wc * 32 + 4 * fq;
#pragma unroll
        for (int m = 0; m < 4; ++m)
#pragma unroll
            for (int n = 0; n < 2; ++n) { uint2 w; w.x = cvt_pk_bf16(acc[m][n][0], acc[m][n][1]); w.y = cvt_pk_bf16(acc[m][n][2], acc[m][n][3]);
                *(uint2*)(O + (size_t)(row0 + m * 16) * ldc + col0 + n * 16) = w; }
    }
    asm volatile("s_waitcnt vmcnt(0)" ::: "memory"); asm volatile("s_waitcnt lgkmcnt(0)" ::: "memory"); __builtin_amdgcn_s_barrier();
}
template <bool UP>
__device__ __forceinline__ void gemm_tail(PG8_LAS unsigned char* lds, const Gemm g, const StaticOrder& S, int full, int U, bf16_t* O, int ldc, const float* gate, int tid_in) {
    const int r = U - full, c = S.c;
    for (int i = 0; i * 64 < r; ++i) { const int idx = 64 * i + (c & 7) * 8 + ((c >> 5) & 7), q = (c >> 3) & 3;
        if (idx < r) { Unit u; S.at(full + idx, u); gemm_quarter<UP>(lds, g, u, q >> 1, q & 1, O, ldc, gate, tid_in); } }
}
}
namespace att {
using bf16 = unsigned short;
using bf16x8 = __attribute__((ext_vector_type(8))) short;
using s16x4  = __attribute__((ext_vector_type(4))) short;
using f32x16 = __attribute__((ext_vector_type(16))) float;
using u32x4  = __attribute__((ext_vector_type(4))) unsigned;
constexpr int NW = 8, QBLK = 32, KVBLK = 64;
#define SBAR() __builtin_amdgcn_sched_barrier(0)
__device__ __forceinline__ int crow(int r, int hi) { return (r & 3) + 8 * (r >> 2) + 4 * hi; }
__device__ __forceinline__ unsigned cvtpk(float lo, float hi) { unsigned r; asm volatile("v_cvt_pk_bf16_f32 %0, %1, %2" : "=v"(r) : "v"(lo), "v"(hi)); return r; }
template <int DH> struct Cfg {
  static constexpr int ROWB = DH * 2, SHM_T = KVBLK * DH * 2, ND0 = DH / 16, NOB = DH / 32, CPR = DH / 8, RPP = 512 / CPR, NPASS = 64 / RPP;
  static constexpr float SCALE = (DH == 128) ? 0.088388347648318440f : 0.125f;
  static constexpr int SHM = 8 * SHM_T;
  static constexpr float CEXP = (DH == 128) ? 1.0f : SCALE * 1.4426950408889634f, THRV = (DH == 128) ? 8.f * 1.4426950408889634f : 8.f / SCALE;
};
template <int DH> __device__ __forceinline__ int kswz(int row, int colB) { return row * Cfg<DH>::ROWB + (colB ^ ((row & 7) << 4)); }

template <int DH>
__device__ __forceinline__ void partialSM(f32x16& p0, f32x16& p1, float& m_reg, float& mn, float& alpha) {
  constexpr float C = Cfg<DH>::CEXP;
  float pmax = p0[0];
#pragma unroll
  for (int r = 1; r < 16; ++r) pmax = fmaxf(pmax, p0[r]);
#pragma unroll
  for (int r = 0; r < 16; ++r) pmax = fmaxf(pmax, p1[r]);
  { auto rr = __builtin_amdgcn_permlane32_swap(__float_as_uint(pmax), __float_as_uint(pmax), false, false);
    pmax = fmaxf(__uint_as_float(rr[0]), __uint_as_float(rr[1])); }
  if (__builtin_expect(__all(pmax - m_reg <= Cfg<DH>::THRV), 1)) { mn = m_reg; alpha = 1.f; }
  else { mn = fmaxf(m_reg, pmax); alpha = __builtin_amdgcn_exp2f((m_reg - mn) * C); m_reg = mn; }
  float mnC = -mn * C;
#pragma unroll
  for (int r = 0; r < 16; ++r) p0[r] = fmaf(p0[r], C, mnC);
#pragma unroll
  for (int r = 0; r < 16; ++r) p1[r] = fmaf(p1[r], C, mnC);
#pragma unroll
  for (int r = 0; r < 16; ++r) p0[r] = __builtin_amdgcn_exp2f(p0[r]);
}
__device__ __forceinline__ void partialSM_nomax(f32x16& p0) {
#pragma unroll
  for (int r = 0; r < 16; ++r) p0[r] = __builtin_amdgcn_exp2f(p0[r]);
}
__device__ __forceinline__ void finishSM(f32x16& p0, f32x16& p1, float alpha, float& l_reg, bf16x8& pa0, bf16x8& pa1, bf16x8& pa2, bf16x8& pa3) {
#pragma unroll
  for (int r = 0; r < 16; ++r) p1[r] = __builtin_amdgcn_exp2f(p1[r]);
  float ps = 0;
#pragma unroll
  for (int r = 0; r < 16; ++r) ps += p0[r];
#pragma unroll
  for (int r = 0; r < 16; ++r) ps += p1[r];
  { auto rr = __builtin_amdgcn_permlane32_swap(__float_as_uint(ps), __float_as_uint(ps), false, false);
    ps = __uint_as_float(rr[0]) + __uint_as_float(rr[1]); }
  l_reg = l_reg * alpha + ps;
#define PK4(P, BASE, OUT) do { unsigned a0 = cvtpk(P[BASE + 0], P[BASE + 1]), a1 = cvtpk(P[BASE + 2], P[BASE + 3]);   \
    unsigned b0 = cvtpk(P[BASE + 4], P[BASE + 5]), b1 = cvtpk(P[BASE + 6], P[BASE + 7]);                              \
    auto r0 = __builtin_amdgcn_permlane32_swap(a0, b0, false, false); auto r1 = __builtin_amdgcn_permlane32_swap(a1, b1, false, false); \
    u32x4 w = {r0[0], r1[0], r0[1], r1[1]}; OUT = *reinterpret_cast<bf16x8*>(&w); } while (0)
  PK4(p0, 0, pa0); PK4(p0, 8, pa1); PK4(p1, 0, pa2); PK4(p1, 8, pa3);
#undef PK4
}
template <int DH>
__device__ __forceinline__ void qkt(f32x16& p0, f32x16& p1, const char* Ks, const bf16x8* qr, int r32, int hi) {
  p0 = f32x16{}; p1 = f32x16{};
#pragma unroll
  for (int d0 = 0; d0 < Cfg<DH>::ND0; ++d0) { int cb = (d0 * 16 + hi * 8) * 2;
    bf16x8 b0 = *reinterpret_cast<const bf16x8*>(Ks + kswz<DH>(r32, cb));
    bf16x8 b1 = *reinterpret_cast<const bf16x8*>(Ks + kswz<DH>(32 + r32, cb));
    p0 = __builtin_amdgcn_mfma_f32_32x32x16_bf16(b0, qr[d0], p0, 0, 0, 0);
    p1 = __builtin_amdgcn_mfma_f32_32x32x16_bf16(b1, qr[d0], p1, 0, 0, 0); }
}
template <int DH> __device__ __forceinline__ int v_st(int k, int c) { const int kk = (k & ~0xC) | ((k & 4) << 1) | ((k & 8) >> 1); return ((kk >> 3) * (DH / 32) + (c >> 5)) * 512 + ((kk & 7) * 32 + (c & 31)) * 2; }
__device__ __forceinline__ int v_rd_base(int lane) { return ((lane & 3) << 3) | (((lane >> 2) & 3) << 6) | (((lane >> 4) & 1) << 5) | (((lane >> 5) & 1) << 8); }
template <int DH> constexpr int v_rd_off(int d0, int ks, int half) { return d0 * 512 + ks * (DH / 32) * 1024 + half * (DH / 32) * 512; }
template <int OFF> __device__ __forceinline__ s16x4 tr_read(int vb) {
  s16x4 r; asm volatile("ds_read_b64_tr_b16 %0, %1 offset:%2" : "=&v"(r) : "v"(vb), "i"(OFF) : "memory"); return r;
}
struct VFrag { s16x4 l0, h0, l1, h1, l2, h2, l3, h3; };
template <int DH, int D0> __device__ __forceinline__ void v_issue(VFrag& f, int vb) {
  f.l0 = tr_read<v_rd_off<DH>(D0, 0, 0)>(vb); f.h0 = tr_read<v_rd_off<DH>(D0, 0, 1)>(vb); f.l1 = tr_read<v_rd_off<DH>(D0, 1, 0)>(vb); f.h1 = tr_read<v_rd_off<DH>(D0, 1, 1)>(vb);
  f.l2 = tr_read<v_rd_off<DH>(D0, 2, 0)>(vb); f.h2 = tr_read<v_rd_off<DH>(D0, 2, 1)>(vb); f.l3 = tr_read<v_rd_off<DH>(D0, 3, 0)>(vb); f.h3 = tr_read<v_rd_off<DH>(D0, 3, 1)>(vb);
}
__device__ __forceinline__ void v_mma(f32x16& od, const VFrag& f, bf16x8 pa0, bf16x8 pa1, bf16x8 pa2, bf16x8 pa3) {
#define PK(L, H) (bf16x8){L[0], L[1], L[2], L[3], H[0], H[1], H[2], H[3]}
  od = __builtin_amdgcn_mfma_f32_32x32x16_bf16(pa0, PK(f.l0, f.h0), od, 0, 0, 0);
  od = __builtin_amdgcn_mfma_f32_32x32x16_bf16(pa1, PK(f.l1, f.h1), od, 0, 0, 0);
  od = __builtin_amdgcn_mfma_f32_32x32x16_bf16(pa2, PK(f.l2, f.h2), od, 0, 0, 0);
  od = __builtin_amdgcn_mfma_f32_32x32x16_bf16(pa3, PK(f.l3, f.h3), od, 0, 0, 0);
#undef PK
}
template <int DH> __device__ __forceinline__ void pv_d0(f32x16* o, int vb, bf16x8 pa0, bf16x8 pa1, bf16x8 pa2, bf16x8 pa3) {
  VFrag fa, fb;
  v_issue<DH, 0>(fa, vb);
  v_issue<DH, 1>(fb, vb); asm volatile("s_waitcnt lgkmcnt(8)" ::: "memory"); SBAR(); v_mma(o[0], fa, pa0, pa1, pa2, pa3); SBAR();
  if constexpr (DH == 128) {
    v_issue<DH, 2>(fa, vb); asm volatile("s_waitcnt lgkmcnt(8)" ::: "memory"); SBAR(); v_mma(o[1], fb, pa0, pa1, pa2, pa3); SBAR();
    v_issue<DH, 3>(fb, vb); asm volatile("s_waitcnt lgkmcnt(8)" ::: "memory"); SBAR(); v_mma(o[2], fa, pa0, pa1, pa2, pa3); SBAR();
    asm volatile("s_waitcnt lgkmcnt(0)" ::: "memory"); SBAR(); v_mma(o[3], fb, pa0, pa1, pa2, pa3);
  } else {
    asm volatile("s_waitcnt lgkmcnt(0)" ::: "memory"); SBAR(); v_mma(o[1], fb, pa0, pa1, pa2, pa3);
  }
}
__device__ __forceinline__ float exp2_s(float x) { float r; asm("v_exp_f32 %0, %1" : "=v"(r) : "v"(x)); return r; }
__device__ __forceinline__ float add_s(float a, float b) { float r; asm("v_add_f32 %0, %1, %2" : "=v"(r) : "v"(a), "v"(b)); return r; }
struct VFrag;
template <int D0, int HALF> __device__ __forceinline__ void v_issue_half(VFrag& f, int vb);
__device__ __forceinline__ void qk_fin_nm(f32x16& x0, f32x16& x1, const char* Ks, const bf16x8* qr, int r32, int hi,
                                          const f32x16& y0, f32x16& y1, float sy0, float& l_reg, bf16x8& pa0, bf16x8& pa1, bf16x8& pa2, bf16x8& pa3, VFrag& vf, int vb);
template <int D0, int HALF> __device__ __forceinline__ void v_issue_half(VFrag& f, int vb) {
  if constexpr (HALF == 0) { f.l0 = tr_read<v_rd_off<128>(D0, 0, 0)>(vb); f.h0 = tr_read<v_rd_off<128>(D0, 0, 1)>(vb); f.l1 = tr_read<v_rd_off<128>(D0, 1, 0)>(vb); f.h1 = tr_read<v_rd_off<128>(D0, 1, 1)>(vb); }
  else                     { f.l2 = tr_read<v_rd_off<128>(D0, 2, 0)>(vb); f.h2 = tr_read<v_rd_off<128>(D0, 2, 1)>(vb); f.l3 = tr_read<v_rd_off<128>(D0, 3, 0)>(vb); f.h3 = tr_read<v_rd_off<128>(D0, 3, 1)>(vb); }
}
__device__ __forceinline__ void qk_fin_nm(f32x16& x0, f32x16& x1, const char* Ks, const bf16x8* qr, int r32, int hi,
                                          const f32x16& y0, f32x16& y1, float sy0, float& l_reg, bf16x8& pa0, bf16x8& pa1, bf16x8& pa2, bf16x8& pa3, VFrag& vf, int vb) {
  x0 = f32x16{}; x1 = f32x16{};
  bf16x8 ka[8], kc[8];
#define LDK(d) do { const int cb_ = ((d) * 16 + hi * 8) * 2; ka[d] = *reinterpret_cast<const bf16x8*>(Ks + kswz<128>(r32, cb_)); kc[d] = *reinterpret_cast<const bf16x8*>(Ks + kswz<128>(32 + r32, cb_)); } while (0)
  LDK(0); LDK(1);
  float s1 = 0.f; unsigned c0[8], c1[8]; unsigned w[4][4];
#define SWP(i, a, b) do { auto r0_ = __builtin_amdgcn_permlane32_swap(c##a[b], c##a[(b) + 2], false, false); auto r1_ = __builtin_amdgcn_permlane32_swap(c##a[(b) + 1], c##a[(b) + 3], false, false); \
    w[i][0] = r0_[0]; w[i][1] = r1_[0]; w[i][2] = r0_[1]; w[i][3] = r1_[1]; } while (0)
#pragma unroll
  for (int t = 0; t < 16; ++t) { const int d0 = t >> 1;
    if ((t & 1) == 0 && d0 + 2 < 8) LDK(d0 + 2);
    if (t & 1) x1 = __builtin_amdgcn_mfma_f32_32x32x16_bf16(kc[d0], qr[d0], x1, 0, 0, 0); else x0 = __builtin_amdgcn_mfma_f32_32x32x16_bf16(ka[d0], qr[d0], x0, 0, 0, 0);
    y1[t] = exp2_s(y1[t]);
    if (t > 0) s1 = add_s(s1, y1[t - 1]);
    if (t < 8) c0[t] = cvtpk(y0[2 * t], y0[2 * t + 1]); else c1[t - 8] = cvtpk(y1[2 * (t - 8)], y1[2 * (t - 8) + 1]);
    if (t == 4) SWP(0, 0, 0);
    if (t == 8) SWP(1, 0, 4);
    if (t == 12) SWP(2, 1, 0);
    if (t == 14) v_issue_half<0, 0>(vf, vb);
    if (t == 15) v_issue_half<0, 1>(vf, vb);
    SBAR(); }
  asm volatile("" : "+v"(x0), "+v"(x1));
  s1 = add_s(s1, y1[15]); SWP(3, 1, 4);
  float ps = sy0 + s1; { auto rr = __builtin_amdgcn_permlane32_swap(__float_as_uint(ps), __float_as_uint(ps), false, false); ps = __uint_as_float(rr[0]) + __uint_as_float(rr[1]); }
  l_reg += ps;
  { u32x4 q0 = {w[0][0], w[0][1], w[0][2], w[0][3]}, q1 = {w[1][0], w[1][1], w[1][2], w[1][3]}, q2 = {w[2][0], w[2][1], w[2][2], w[2][3]}, q3 = {w[3][0], w[3][1], w[3][2], w[3][3]};
    pa0 = __builtin_bit_cast(bf16x8, q0); pa1 = __builtin_bit_cast(bf16x8, q1); pa2 = __builtin_bit_cast(bf16x8, q2); pa3 = __builtin_bit_cast(bf16x8, q3); }
#undef LDK
#undef SWP
}
#define PVPK(L, H) (bf16x8){L[0], L[1], L[2], L[3], H[0], H[1], H[2], H[3]}
struct StageW { char* d0; char* d1; bf16x8 v0, v1; };
template <int G> __device__ __forceinline__ void pv_block_nm(f32x16& od, VFrag& cur, VFrag& nxt, int vb, bf16x8 pa0, bf16x8 pa1, bf16x8 pa2, bf16x8 pa3, f32x16& x0, float& sx, const StageW* sw = nullptr) {
  od = __builtin_amdgcn_mfma_f32_32x32x16_bf16(pa0, PVPK(cur.l0, cur.h0), od, 0, 0, 0); x0[4 * G + 0] = exp2_s(x0[4 * G + 0]); if constexpr (G > 0) sx = add_s(sx, x0[4 * G - 1]); if constexpr (G < 3) v_issue_half<G + 1, 0>(nxt, vb); SBAR();
  od = __builtin_amdgcn_mfma_f32_32x32x16_bf16(pa1, PVPK(cur.l1, cur.h1), od, 0, 0, 0); x0[4 * G + 1] = exp2_s(x0[4 * G + 1]); sx = add_s(sx, x0[4 * G + 0]); if constexpr (G < 3) v_issue_half<G + 1, 1>(nxt, vb); SBAR();
  od = __builtin_amdgcn_mfma_f32_32x32x16_bf16(pa2, PVPK(cur.l2, cur.h2), od, 0, 0, 0); x0[4 * G + 2] = exp2_s(x0[4 * G + 2]); sx = add_s(sx, x0[4 * G + 1]); if (sw) *(bf16x8*)sw->d0 = sw->v0; SBAR();
  od = __builtin_amdgcn_mfma_f32_32x32x16_bf16(pa3, PVPK(cur.l3, cur.h3), od, 0, 0, 0); x0[4 * G + 3] = exp2_s(x0[4 * G + 3]); sx = add_s(sx, x0[4 * G + 2]); if (sw) *(bf16x8*)sw->d1 = sw->v1; SBAR();
  if constexpr (G < 3) { asm volatile("s_waitcnt lgkmcnt(0)" ::: "memory"); SBAR(); }
}
__device__ __forceinline__ void pv_psm_nm(f32x16* o, int vb, bf16x8 pa0, bf16x8 pa1, bf16x8 pa2, bf16x8 pa3, f32x16& x0, float& sx, VFrag& fa, const StageW* swv = nullptr, const StageW* swk = nullptr) {
  VFrag fb;
  asm volatile("s_waitcnt lgkmcnt(0)" ::: "memory"); SBAR();
  sx = 0.f;
  pv_block_nm<0>(o[0], fa, fb, vb, pa0, pa1, pa2, pa3, x0, sx);
  pv_block_nm<1>(o[1], fb, fa, vb, pa0, pa1, pa2, pa3, x0, sx);
  pv_block_nm<2>(o[2], fa, fb, vb, pa0, pa1, pa2, pa3, x0, sx, swv);
  pv_block_nm<3>(o[3], fb, fa, vb, pa0, pa1, pa2, pa3, x0, sx, swk);
  sx = add_s(sx, x0[15]);
  asm volatile("" : "+v"(o[0]), "+v"(o[1]), "+v"(o[2]), "+v"(o[3]));
}
#undef PVPK
struct StageRegs { bf16x8 vs[2], ks[2]; };
__device__ __forceinline__ int vtswz(int d, int colB) { return d * 128 + (colB ^ (((d >> 1) & 7) << 4)); }
__device__ __forceinline__ void attn_step_nm(f32x16& x0, f32x16& x1, const f32x16& y0, f32x16& y1, float sy0, float& sx0, float& l_reg, f32x16* o, const bf16x8* qr, int r32, int hi,
                                             const char* Kcur, const char* Vtprev,
                                             StageRegs& ld, const bf16* vsrc, long vstride, const bf16* ksrc, long kstride, const StageRegs& wr, char* vdst0, char* vdst1, char* kdst0, char* kdst1) {
  x0 = f32x16{}; x1 = f32x16{};
  bf16x8 ka[8], kc[8];
#define LDK(d, base) do { const int cb_ = ((d) * 16 + hi * 8) * 2; ka[d] = *reinterpret_cast<const bf16x8*>((base) + kswz<128>(r32, cb_)); kc[d] = *reinterpret_cast<const bf16x8*>((base) + kswz<128>(32 + r32, cb_)); } while (0)
#define LDV(G, ks) (*reinterpret_cast<const bf16x8*>(Vtprev + vtswz(32 * (G) + r32, (2 * (ks) + hi) * 16)))
  float s1 = 0.f; unsigned c0[8], c1[8];
  bf16x8 va[4], vb[4];
#pragma unroll
  for (int t = 0; t < 16; ++t) { const int d0 = t >> 1;
    if (t == 0) { LDK(0, Kcur); LDK(1, Kcur); }
    if ((t & 1) == 0 && d0 + 2 < 8) LDK(d0 + 2, Kcur);
    if (t & 1) x1 = __builtin_amdgcn_mfma_f32_32x32x16_bf16(kc[d0], qr[d0], x1, 0, 0, 0); else x0 = __builtin_amdgcn_mfma_f32_32x32x16_bf16(ka[d0], qr[d0], x0, 0, 0, 0);
    y1[t] = exp2_s(y1[t]);
    if (t > 0) s1 = add_s(s1, y1[t - 1]);
    if (t < 8) c0[t] = cvtpk(y0[2 * t], y0[2 * t + 1]); else if (t < 15) c1[t - 8] = cvtpk(y1[2 * (t - 8)], y1[2 * (t - 8) + 1]);
    if (t == 1) { ld.vs[0] = *reinterpret_cast<const bf16x8*>(vsrc); ld.vs[1] = *reinterpret_cast<const bf16x8*>(vsrc + vstride); ld.ks[0] = *reinterpret_cast<const bf16x8*>(ksrc); ld.ks[1] = *reinterpret_cast<const bf16x8*>(ksrc + kstride); }
    if (t == 14) { va[0] = LDV(0, 0); va[1] = LDV(0, 1); }
    if (t == 15) { va[2] = LDV(0, 2); va[3] = LDV(0, 3); }
    SBAR(); }
  asm volatile("" : "+v"(x0), "+v"(x1));
  bf16x8 pf0, pf1, pf2, pf3;
  { u32x4 q0 = {c0[0], c0[1], c0[2], c0[3]}, q1 = {c0[4], c0[5], c0[6], c0[7]}, q2 = {c1[0], c1[1], c1[2], c1[3]};
    pf0 = __builtin_bit_cast(bf16x8, q0); pf1 = __builtin_bit_cast(bf16x8, q1); pf2 = __builtin_bit_cast(bf16x8, q2); }
#define PVM(G, i, F, PF) o[G] = __builtin_amdgcn_mfma_f32_32x32x16_bf16(F[i], PF, o[G], 0, 0, 0); x0[4 * G + i] = exp2_s(x0[4 * G + i])
  float sx = 0.f;
  PVM(0, 0, va, pf0); c1[7] = cvtpk(y1[14], y1[15]); s1 = add_s(s1, y1[15]); vb[0] = LDV(1, 0); vb[1] = LDV(1, 1); SBAR();
  PVM(0, 1, va, pf1); sx = add_s(sx, x0[0]); vb[2] = LDV(1, 2); vb[3] = LDV(1, 3); SBAR();
  { u32x4 q3 = {c1[4], c1[5], c1[6], c1[7]}; pf3 = __builtin_bit_cast(bf16x8, q3); }
  PVM(0, 2, va, pf2); sx = add_s(sx, x0[1]); float ps = sy0 + s1; SBAR();
  PVM(0, 3, va, pf3); sx = add_s(sx, x0[2]); { auto rr = __builtin_amdgcn_permlane32_swap(__float_as_uint(ps), __float_as_uint(ps), false, false); ps = __uint_as_float(rr[0]) + __uint_as_float(rr[1]); } l_reg += ps; SBAR();
  PVM(1, 0, vb, pf0); sx = add_s(sx, x0[3]); va[0] = LDV(2, 0); va[1] = LDV(2, 1); SBAR();
  PVM(1, 1, vb, pf1); sx = add_s(sx, x0[4]); va[2] = LDV(2, 2); va[3] = LDV(2, 3); SBAR();
  PVM(1, 2, vb, pf2); sx = add_s(sx, x0[5]); SBAR();
  PVM(1, 3, vb, pf3); sx = add_s(sx, x0[6]); SBAR();
  PVM(2, 0, va, pf0); sx = add_s(sx, x0[7]); vb[0] = LDV(3, 0); vb[1] = LDV(3, 1); SBAR();
  PVM(2, 1, va, pf1); sx = add_s(sx, x0[8]); vb[2] = LDV(3, 2); vb[3] = LDV(3, 3); SBAR();
  PVM(2, 2, va, pf2); sx = add_s(sx, x0[9]); *(bf16x8*)vdst0 = wr.vs[0]; SBAR();
  PVM(2, 3, va, pf3); sx = add_s(sx, x0[10]); *(bf16x8*)vdst1 = wr.vs[1]; SBAR();
  PVM(3, 0, vb, pf0); sx = add_s(sx, x0[11]); SBAR();
  PVM(3, 1, vb, pf1); sx = add_s(sx, x0[12]); SBAR();
  PVM(3, 2, vb, pf2); sx = add_s(sx, x0[13]); *(bf16x8*)kdst0 = wr.ks[0]; SBAR();
  PVM(3, 3, vb, pf3); sx = add_s(sx, x0[14]); *(bf16x8*)kdst1 = wr.ks[1]; SBAR();
  sx0 = add_s(sx, x0[15]);
  asm volatile("" : "+v"(o[0]), "+v"(o[1]), "+v"(o[2]), "+v"(o[3]));
#undef LDK
#undef LDV
#undef PVM
}
__device__ __forceinline__ void finish_t(const f32x16& y0, f32x16& y1, float& l_reg, bf16x8 (&pf)[4]) {
#pragma unroll
  for (int r = 0; r < 16; ++r) y1[r] = __builtin_amdgcn_exp2f(y1[r]);
  float ps = 0.f;
#pragma unroll
  for (int r = 0; r < 16; ++r) ps += y0[r] + y1[r];
  { auto rr = __builtin_amdgcn_permlane32_swap(__float_as_uint(ps), __float_as_uint(ps), false, false); ps = __uint_as_float(rr[0]) + __uint_as_float(rr[1]); }
  l_reg += ps;
#pragma unroll
  for (int s_ = 0; s_ < 2; ++s_) { u32x4 a = {cvtpk(y0[8 * s_], y0[8 * s_ + 1]), cvtpk(y0[8 * s_ + 2], y0[8 * s_ + 3]), cvtpk(y0[8 * s_ + 4], y0[8 * s_ + 5]), cvtpk(y0[8 * s_ + 6], y0[8 * s_ + 7])};
    u32x4 c = {cvtpk(y1[8 * s_], y1[8 * s_ + 1]), cvtpk(y1[8 * s_ + 2], y1[8 * s_ + 3]), cvtpk(y1[8 * s_ + 4], y1[8 * s_ + 5]), cvtpk(y1[8 * s_ + 6], y1[8 * s_ + 7])};
    pf[s_] = __builtin_bit_cast(bf16x8, a); pf[2 + s_] = __builtin_bit_cast(bf16x8, c); }
}
__device__ __forceinline__ void pv_t(f32x16* o, const char* Vt, const bf16x8 (&pf)[4], int r32, int hi) {
#pragma unroll
  for (int G = 0; G < 4; ++G)
#pragma unroll
    for (int ks = 0; ks < 4; ++ks) o[G] = __builtin_amdgcn_mfma_f32_32x32x16_bf16(*reinterpret_cast<const bf16x8*>(Vt + vtswz(32 * G + r32, (2 * ks + hi) * 16)), pf[ks], o[G], 0, 0, 0);
}
__device__ __forceinline__ void swa_mask(f32x16& p0, f32x16& p1, int kt0, int qt, int hi, int seq) {
#pragma unroll
  for (int r = 0; r < 16; ++r) { const int k0 = kt0 + crow(r, hi), k1 = k0 + 32; const int d0 = k0 - qt, d1 = k1 - qt;
    const bool v0 = (k0 >= 0) && (k0 < seq) && (d0 <= 128) && (d0 >= -128); const bool v1 = (k1 >= 0) && (k1 < seq) && (d1 <= 128) && (d1 >= -128);
    p0[r] = v0 ? p0[r] : -1e30f; p1[r] = v1 ? p1[r] : -1e30f; }
}
template <int DH, bool SWA, int ldq, int ldk, int ldo, int seq, bool NOMAX = false, bool QPRO = false>
__device__ __forceinline__ void attn_unit(const bf16* __restrict__ Qb, const bf16* __restrict__ Kb, const bf16* __restrict__ Vb,
                                          bf16* __restrict__ Ob, int NT, int t0, bool has_sink, float sink, char* lds,
                                          int tid_in, const float* __restrict__ qgain = nullptr, const float* __restrict__ cosT = nullptr, const float* __restrict__ sinT = nullptr, int tq0 = -1,
                                          const bf16* __restrict__ Vtb = nullptr, int vtpitch = 0) {
  using C = Cfg<DH>;
  constexpr int SHM_T = C::SHM_T, NPASS = C::NPASS, RPP = C::RPP, CPR = C::CPR;
  int tid_l = HW_TID(tid_in  ); asm volatile("" : "+v"(tid_l));
  const int tid = tid_l, wid = tid_in  , lane = tid & 63, r32 = lane & 31, hi = lane >> 5;
  constexpr int NS = (NOMAX && DH == 128 && !SWA) ? 4 : 2;
  char* V_lds = lds; char* K_lds = lds + NS * SHM_T;
  float* ws = (float*)(lds + (NS == 4 ? 131072 + 1024 : 2 * NS * SHM_T)) + wid * 64; float* li_l = ws; float* al_l = ws + 32;
  float m_reg = -1e30f, l_reg = 0; f32x16 o[C::NOB] = {}; bf16x8 qr[C::ND0];
  const bf16* Qw = Qb + (long)(wid * QBLK + r32) * ldq + hi * 8;
#pragma unroll
  for (int d0 = 0; d0 < C::ND0; ++d0) qr[d0] = *reinterpret_cast<const bf16x8*>(Qw + d0 * 16);
  if constexpr (QPRO) {
    static_assert(DH == 128, "QPRO is written for head dim 128");
    float qf[8][8]; float ss = 0.f;
#pragma unroll
    for (int d0 = 0; d0 < 8; ++d0) { const u32x4 w = __builtin_bit_cast(u32x4, qr[d0]);
#pragma unroll
      for (int e = 0; e < 4; ++e) { qf[d0][2 * e] = __uint_as_float(w[e] << 16); qf[d0][2 * e + 1] = __uint_as_float(w[e] & 0xffff0000u); }
#pragma unroll
      for (int e = 0; e < 8; ++e) ss = fmaf(qf[d0][e], qf[d0][e], ss); }
    { auto rr = __builtin_amdgcn_permlane32_swap(__float_as_uint(ss), __float_as_uint(ss), false, false); ss = __uint_as_float(rr[0]) + __uint_as_float(rr[1]); }
    const float rs = 0.12751741437781343f / sqrtf(ss * (1.0f / 128.f) + 1e-6f);
#pragma unroll
    for (int d0 = 0; d0 < 8; ++d0) { const float* gp = qgain + d0 * 16 + hi * 8;
#pragma unroll
      for (int e = 0; e < 8; ++e) qf[d0][e] *= rs * gp[e]; }
    if (tq0 >= 0) { const int t = tq0 + wid * QBLK + r32;
#pragma unroll
      for (int ax = 0; ax < 2; ++ax) { const int pos = ax ? (t & 63) : (t >> 6);
#pragma unroll
        for (int dd = 0; dd < 2; ++dd) { const int d0 = ax * 4 + dd; const float* cp = cosT + pos * 32 + dd * 16 + hi * 8; const float* sp = sinT + pos * 32 + dd * 16 + hi * 8;
#pragma unroll
          for (int e = 0; e < 8; ++e) { const float c = cp[e], sn = sp[e], x1 = qf[d0][e], x2 = qf[d0 + 2][e]; qf[d0][e] = x1 * c - x2 * sn; qf[d0 + 2][e] = x2 * c + x1 * sn; } } } }
#pragma unroll
    for (int d0 = 0; d0 < 8; ++d0) { u32x4 w = {cvtpk(qf[d0][0], qf[d0][1]), cvtpk(qf[d0][2], qf[d0][3]), cvtpk(qf[d0][4], qf[d0][5]), cvtpk(qf[d0][6], qf[d0][7])}; qr[d0] = __builtin_bit_cast(bf16x8, w); }
  }
  const int sr = tid / CPR, sc = (tid % CPR) * 8;
  int vst[NPASS], kst[NPASS];
#pragma unroll
  for (int i = 0; i < NPASS; ++i) { vst[i] = v_st<DH>(sr + i * RPP, sc); kst[i] = kswz<DH>(sr + i * RPP, sc * 2); }
  const int vb0 = (int)(uintptr_t)V_lds + v_rd_base(lane);
  struct { bf16x8 vs[NPASS], ks[NPASS]; } sr_[2];
  const int qt = t0 + wid * QBLK + r32;
  auto trow = [&](int j) -> long { if constexpr (!SWA) return (long)j * KVBLK; else { if (j < 4) return (long)j * KVBLK; int t = t0 - 128 + (j - 4) * KVBLK; t = t < 0 ? 0 : (t > seq - KVBLK ? seq - KVBLK : t); return 256L + t; } };
#define SLOAD(i, j_) do { const long k0_ = trow(j_); _Pragma("unroll") for (int q_ = 0; q_ < NPASS; ++q_) { \
    sr_[i].vs[q_] = *reinterpret_cast<const bf16x8*>(&Vb[(k0_ + sr + q_ * RPP) * ldk + sc]); sr_[i].ks[q_] = *reinterpret_cast<const bf16x8*>(&Kb[(k0_ + sr + q_ * RPP) * ldk + sc]); } } while (0)
#define SWRITE(b, i) do { _Pragma("unroll") for (int q_ = 0; q_ < NPASS; ++q_) { *(bf16x8*)(V_lds + (b) * SHM_T + vst[q_]) = sr_[i].vs[q_]; *(bf16x8*)(K_lds + (b) * SHM_T + kst[q_]) = sr_[i].ks[q_]; } } while (0)
#define SWAIT() do { if constexpr (NPASS == 2) asm volatile("s_waitcnt vmcnt(4)" ::: "memory"); else asm volatile("s_waitcnt vmcnt(2)" ::: "memory"); } while (0)
#define RESC(a) do { if constexpr (!NOMAX) if (__any((a) < 1.f)) { if (hi == 0) al_l[r32] = (a); asm volatile("s_waitcnt lgkmcnt(0)" ::: "memory"); \
    _Pragma("unroll") for (int d = 0; d < C::NOB; ++d) _Pragma("unroll") for (int r = 0; r < 16; ++r) o[d][r] *= al_l[crow(r, hi)]; } } while (0)
#define PSM(P0, P1, MN, AL) do { if constexpr (NOMAX) { partialSM_nomax(P0); AL = 1.f; } else partialSM<DH>(P0, P1, m_reg, MN, AL); } while (0)
#define MASK(P0, P1, j_) do { if constexpr (SWA) { if ((j_) >= 4) { const int kt_ = t0 - 128 + ((j_) - 4) * KVBLK, q0_ = t0 + wid * QBLK; \
    if (!(kt_ >= q0_ + 31 - 128 && kt_ + 63 <= q0_ + 128)) swa_mask(P0, P1, kt_, qt, hi, seq); } } } while (0)
  f32x16 pA0, pA1, pB0, pB1; float mnA, mnB, alA, alB; bf16x8 pa0, pa1, pa2, pa3;
  constexpr int SE = 0, SO = 1;
  auto act = [&](int j) -> bool { if constexpr (!SWA) return true; else { if (j < 4) return true; const int m = j - 4, kt_ = t0 - 128 + m * KVBLK; return m >= (wid >> 1) && m <= (wid >> 1) + 4 && kt_ >= 0 && kt_ < seq; } };
  if constexpr (NOMAX && DH == 128 && !SWA) {
    const int sr2 = tid >> 3, c2 = tid & 7;
    int vtst[2];
#pragma unroll
    for (int q_ = 0; q_ < 2; ++q_) vtst[q_] = vtswz(sr2 + 64 * q_, 16 * c2);
#define SWRITEO(boff, R) do { _Pragma("unroll") for (int q_ = 0; q_ < NPASS; ++q_) { *(bf16x8*)(V_lds + (boff) + vtst[q_]) = R.vs[q_]; *(bf16x8*)(K_lds + (boff) + kst[q_]) = R.ks[q_]; } } while (0)
#define GLOAD(R, j_) do { const long jt_ = (j_) < NT ? (j_) : NT - 1; const long k0_ = trow(jt_); _Pragma("unroll") for (int q_ = 0; q_ < NPASS; ++q_) { \
      R.vs[q_] = *reinterpret_cast<const bf16x8*>(&Vtb[(long)(sr2 + 64 * q_) * vtpitch + 64 * jt_ + 8 * c2]); R.ks[q_] = *reinterpret_cast<const bf16x8*>(&Kb[(k0_ + sr + q_ * RPP) * ldk + sc]); } } while (0)
#define ROT4() do { const int t_ = bq; bq = bc; bc = bn; bn = bw; bw = t_; } while (0)
    static_assert(NPASS == 2, "hand-placed path: two 16-byte pieces per matrix per thread");
    StageRegs rA, rB;
    { StageRegs rC; GLOAD(rA, 0); GLOAD(rB, 1); GLOAD(rC, 2);
      __syncthreads();
      asm volatile("s_waitcnt vmcnt(8)" ::: "memory"); SWRITEO(0, rA); asm volatile("s_waitcnt vmcnt(4)" ::: "memory"); SWRITEO(SHM_T, rB);
      GLOAD(rB, 3); asm volatile("s_waitcnt vmcnt(4)" ::: "memory"); SWRITEO(2 * SHM_T, rC); __syncthreads(); }
    qkt<DH>(pA0, pA1, K_lds, qr, r32, hi); partialSM_nomax(pA0);
    float sA = 0.f, sB = 0.f;
#pragma unroll
    for (int r = 0; r < 16; ++r) sA += pA0[r];
    int bq = 0, bc = SHM_T, bn = 2 * SHM_T, bw = 3 * SHM_T;
    const long kstride = (long)RPP * ldk, vstride = 64L * vtpitch;
    for (int j = 1; j + 1 < NT; j += 2) {
      { const long jt_ = j + 3 < NT ? j + 3 : NT - 1; const long k0_ = trow(jt_);
        attn_step_nm(pB0, pB1, pA0, pA1, sA, sB, l_reg, o, qr, r32, hi, K_lds + bc, V_lds + bq,
                     rA, &Vtb[(long)sr2 * vtpitch + 64 * jt_ + 8 * c2], vstride, &Kb[(k0_ + sr) * ldk + sc], kstride, rB, V_lds + bw + vtst[0], V_lds + bw + vtst[1], K_lds + bw + kst[0], K_lds + bw + kst[1]); }
      __syncthreads(); ROT4();
      { const long jt_ = j + 4 < NT ? j + 4 : NT - 1; const long k0_ = trow(jt_);
        attn_step_nm(pA0, pA1, pB0, pB1, sB, sA, l_reg, o, qr, r32, hi, K_lds + bc, V_lds + bq,
                     rB, &Vtb[(long)sr2 * vtpitch + 64 * jt_ + 8 * c2], vstride, &Kb[(k0_ + sr) * ldk + sc], kstride, rA, V_lds + bw + vtst[0], V_lds + bw + vtst[1], K_lds + bw + kst[0], K_lds + bw + kst[1]); }
      __syncthreads(); ROT4();
    }
    { bf16x8 pf[4];
      SBAR(); qkt<DH>(pB0, pB1, K_lds + bc, qr, r32, hi);
      finish_t(pA0, pA1, l_reg, pf); SBAR();
      pv_t(o, V_lds + bq, pf, r32, hi); partialSM_nomax(pB0);
      finish_t(pB0, pB1, l_reg, pf); SBAR();
      pv_t(o, V_lds + bc, pf, r32, hi); }
    { const float rl = __builtin_amdgcn_rcpf(l_reg); bf16* Orow = Ob + (long)(wid * QBLK + r32) * ldo + 4 * hi;
#pragma unroll
      for (int G = 0; G < 4; ++G)
#pragma unroll
        for (int qd = 0; qd < 4; ++qd) { u32x4 dummy; (void)dummy; unsigned w0 = cvtpk(o[G][4 * qd] * rl, o[G][4 * qd + 1] * rl), w1 = cvtpk(o[G][4 * qd + 2] * rl, o[G][4 * qd + 3] * rl);
          typedef unsigned u32x2_t __attribute__((ext_vector_type(2))); u32x2_t w = {w0, w1}; *(u32x2_t*)(Orow + 32 * G + 8 * qd) = w; } }
    return;
#undef GLOAD
#undef ROT4
#undef SWRITEO
  } else {
  SLOAD(SE, 0); SLOAD(SO, 1); SWAIT(); SWRITE(0, SE); __syncthreads();
  qkt<DH>(pA0, pA1, K_lds, qr, r32, hi); PSM(pA0, pA1, mnA, alA);
  if (2 < NT) { SLOAD(SE, 2); SWAIT(); } else asm volatile("s_waitcnt vmcnt(0)" ::: "memory");
  SWRITE(1, SO); __syncthreads();
  bool aA = true, aB = true;
  for (int j = 1; j + 1 < NT; j += 2) {
    aB = act(j);
    SBAR(); if (aB) { qkt<DH>(pB0, pB1, K_lds + SHM_T, qr, r32, hi); MASK(pB0, pB1, j); }
    if (aA) finishSM(pA0, pA1, alA, l_reg, pa0, pa1, pa2, pa3); SBAR();
    SLOAD(SO, j + 2); SBAR();
    if (aA) pv_d0<DH>(o, vb0, pa0, pa1, pa2, pa3);
    if (aB) PSM(pB0, pB1, mnB, alB); else alB = 1.f;
    __syncthreads(); SWAIT(); SWRITE(0, SE);
    RESC(alB); __syncthreads();
    aA = act(j + 1);
    SBAR(); if (aA) { qkt<DH>(pA0, pA1, K_lds, qr, r32, hi); MASK(pA0, pA1, j + 1); }
    if (aB) finishSM(pB0, pB1, alB, l_reg, pa0, pa1, pa2, pa3); SBAR();
    if (j + 3 < NT) SLOAD(SE, j + 3); SBAR();
    if (aB) pv_d0<DH>(o, vb0 + SHM_T, pa0, pa1, pa2, pa3);
    if (aA) PSM(pA0, pA1, mnA, alA); else alA = 1.f;
    __syncthreads(); SWAIT(); SWRITE(1, SO);
    RESC(alA); __syncthreads();
  }
  aB = act(NT - 1);
  SBAR(); if (aB) { qkt<DH>(pB0, pB1, K_lds + SHM_T, qr, r32, hi); MASK(pB0, pB1, NT - 1); }
  if (aA) finishSM(pA0, pA1, alA, l_reg, pa0, pa1, pa2, pa3); SBAR();
  if (aA) pv_d0<DH>(o, vb0, pa0, pa1, pa2, pa3);
  if (aB) PSM(pB0, pB1, mnB, alB); else alB = 1.f;
  __syncthreads(); RESC(alB);
  if (aB) { finishSM(pB0, pB1, alB, l_reg, pa0, pa1, pa2, pa3); SBAR();
            pv_d0<DH>(o, vb0 + SHM_T, pa0, pa1, pa2, pa3); }
  }
  if (has_sink) l_reg += __builtin_amdgcn_exp2f(sink * 1.4426950408889634f - m_reg * (C::SCALE * 1.4426950408889634f));
  if (hi == 0) li_l[r32] = l_reg; asm volatile("s_waitcnt lgkmcnt(0)" ::: "memory");
  float rli[16];
#pragma unroll
  for (int r = 0; r < 16; ++r) rli[r] = __builtin_amdgcn_rcpf(li_l[crow(r, hi)]);
  bf16* Ow = Ob + (long)(wid * QBLK) * ldo;
#pragma unroll
  for (int r = 0; r < 16; ++r) { const int orow = crow(r, hi);
#pragma unroll
    for (int d0 = 0; d0 < C::NOB; ++d0) { const float v = o[d0][r] * rli[r]; Ow[(long)orow * ldo + d0 * 32 + r32] = (bf16)(cvtpk(v, v) & 0xffffu); } }
#undef SLOAD
#undef SWRITE
#undef SWAIT
#undef RESC
#undef MASK
#undef PSM
}
#undef SBAR
__device__ __forceinline__ void sbar_() { __builtin_amdgcn_sched_barrier(0); }
}
constexpr int DM = 1024, NBATCH = 2, SEQ = 16384, NCTX = 256, RPB = SEQ + NCTX, NR = NBATCH * RPB, NCHUNK = RPB / 128;
constexpr int NEXP = 16, DEXP = 512;
constexpr int MAXPAN = NR * 2 / 256 + NEXP, MAXSLOT = MAXPAN * 256;
constexpr float ALPHA = 1.6817928305074290f, LN_EPS = 1e-6f, RMS_EPS = 1e-6f;
constexpr int QKV_B = 1280, QKV_C = 1536;
constexpr int NGRID = 256, NWAVES = 8, NTHREADS = 512;
constexpr int NPHASE = 2 + 9 * 4;
#ifndef MK_MULTI
#define MK_MULTI 0
#endif
constexpr size_t MiB = 1u << 20;
constexpr size_t WS_CTL = 0, CTL_ZERO_BYTES = 1 * MiB;
constexpr size_t WS_MOD = 1 * MiB;
constexpr size_t WS_ROPE = WS_MOD + 512 * 1024;
constexpr size_t WS_LAM = 2 * MiB;
constexpr size_t WS_DFR = WS_LAM + 256 * 1024;
constexpr size_t WS_FTAB = WS_LAM + 512 * 1024;
constexpr size_t WS_BBF = 3 * MiB;
constexpr size_t WS_CMF = 4 * MiB;
constexpr size_t WS_ROUTE = 6 * MiB;
constexpr size_t WS_CNTB = 8 * MiB;
constexpr size_t WS_PANE = WS_CNTB + 64 * 1024;
constexpr size_t WS_GSLOT = 9 * MiB;
constexpr size_t WS_ROWMAP = 9 * MiB + 512 * 1024;
constexpr size_t WS_E = 12 * MiB;
constexpr size_t WS_HIN = 29 * MiB;
constexpr size_t WS_WGLU = 46 * MiB;
constexpr size_t WS_WQKVB = 54 * MiB, WS_WOB = 57 * MiB, WS_WQKVC = 59 * MiB, WS_WOC = 62 * MiB;
constexpr size_t WS_WUP = 64 * MiB;
constexpr size_t WS_WDN = 96 * MiB;
constexpr size_t WS_H = 112 * MiB;
constexpr size_t WS_T = 177 * MiB;
constexpr size_t WS_QKV = WS_T, WS_O = WS_T + 98 * MiB, WS_Y = WS_T + 163 * MiB;
constexpr size_t WS_HS = WS_T, WS_ACT = WS_T + 138 * MiB;
constexpr size_t WS_X = WS_T + 228 * MiB;
constexpr size_t WS_S5T = WS_X + 65 * MiB;
constexpr size_t WS_KT = WS_S5T + 10 * MiB;
constexpr size_t WS_VT = WS_KT + 1 * MiB;
constexpr size_t WS_END = WS_VT + 17 * MiB;
static_assert((size_t)(NR + 128) * QKV_C * 2 <= 98 * MiB && (size_t)NR * DM * 2 <= 65 * MiB && (size_t)MAXSLOT * DM * 2 <= 138 * MiB && (size_t)MAXSLOT * DEXP * 2 <= 69 * MiB, "temp map");
static_assert((size_t)2 * NCHUNK * 2 * 64 * 128 * 4 <= 17 * MiB, "E map");
constexpr int CW_BAR = 4096;
constexpr int RING_BYTES = 131072, LDSCTL_OFF = RING_BYTES, MISC_OFF = LDSCTL_OFF + 320, LDS_BYTES = 147456;

typedef unsigned short bf16;
typedef unsigned v4u __attribute__((ext_vector_type(4)));
typedef unsigned v2u __attribute__((ext_vector_type(2)));
typedef float f32x4 __attribute__((ext_vector_type(4)));
typedef float f32x16 __attribute__((ext_vector_type(16)));
typedef short bf16x8 __attribute__((ext_vector_type(8)));
typedef short s16x4 __attribute__((ext_vector_type(4)));
#define LAS __attribute__((address_space(3)))
#define LDS_WAIT() asm volatile("s_waitcnt lgkmcnt(0)" ::: "memory")
__device__ __forceinline__ unsigned pk2(float lo, float hi) { unsigned r; asm("v_cvt_pk_bf16_f32 %0, %1, %2" : "=v"(r) : "v"(lo), "v"(hi)); return r; }
__device__ __forceinline__ unsigned f2bf(float f) { return pk2(f, f) & 0xffffu; }
__device__ __forceinline__ float bf2f(unsigned short h) { return __builtin_bit_cast(float, (unsigned)h << 16); }
__device__ __forceinline__ float bflo(unsigned w) { return __builtin_bit_cast(float, w << 16); }
__device__ __forceinline__ float bfhi(unsigned w) { return __builtin_bit_cast(float, w & 0xffff0000u); }
__device__ __forceinline__ float wave_sum(float v) {
#define DPPF(x, ctrl, rmask) __builtin_bit_cast(float, __builtin_amdgcn_update_dpp(0, __builtin_bit_cast(int, (x)), (ctrl), (rmask), 0xf, false))
    v += DPPF(v, 0xb1, 0xf);
    v += DPPF(v, 0x4e, 0xf);
    v += DPPF(v, 0x124, 0xf);
    v += DPPF(v, 0x128, 0xf);
    v += DPPF(v, 0x142, 0xa);
    v += DPPF(v, 0x143, 0xc);
#undef DPPF
    return __builtin_bit_cast(float, __builtin_amdgcn_readlane(__builtin_bit_cast(int, v), 63));
}
#define XB_TMO      128
#define XB_XCNT(j)  (256  + 64 * (j))
#define XB_XSUB(j)  (1280 + 64 * (j))
#define XB_XGEN(j)  (2304 + 64 * (j))
#define XB_TOP      3328
#define XB_TOPGEN   3392
#define XCD_BAR_WORDS 3456
#define XB_SPIN_CAP (1u << 20)

__device__ __forceinline__ unsigned xb_ld(unsigned* p)              { return __hip_atomic_load(p, __ATOMIC_RELAXED, __HIP_MEMORY_SCOPE_AGENT); }
__device__ __forceinline__ unsigned xb_add(unsigned* p, unsigned v) { return __hip_atomic_fetch_add(p, v, __ATOMIC_RELAXED, __HIP_MEMORY_SCOPE_AGENT); }
__device__ __forceinline__ unsigned xb_xcc_id() { return (unsigned)__builtin_amdgcn_s_getreg((3 << 11) | 20) & 0xFu; }
#define XB_SPIN(cond, bar) do { unsigned _sp = 0; while (cond) { __builtin_amdgcn_s_sleep(1); \
    if ((++_sp & 255u) == 0u) { if (xb_ld(&(bar)[XB_TMO])) break; if (_sp > XB_SPIN_CAP) { atomicAdd(&(bar)[XB_TMO], 1u); break; } } } } while (0)

struct XcdBarrier {
    unsigned* bar; unsigned x;
    volatile LAS unsigned* st;
};

__device__ __forceinline__ XcdBarrier xcd_barrier_post(unsigned* bar, volatile LAS unsigned* st) {
    XcdBarrier b; b.bar = bar; b.x = xb_xcc_id(); b.st = st;
    if (threadIdx.x == 0) (void)xb_add(&bar[XB_XCNT(b.x)], 1u);
    return b;
}
__device__ __forceinline__ void xcd_barrier_complete(unsigned* bar, unsigned x, unsigned& nloc, unsigned& nx) {
    const unsigned G = gridDim.x * gridDim.y * gridDim.z;
    unsigned sum, cnt, mine, sp = 0u;
    for (;;) {
        sum = 0u; cnt = 0u; mine = 0u;
#pragma unroll
        for (unsigned j = 0; j < 16; ++j) { const unsigned c = xb_ld(&bar[XB_XCNT(j)]); sum += c; cnt += (c > 0u) ? 1u : 0u; mine = (j == x) ? c : mine; }
        if (sum == G) break;
        __builtin_amdgcn_s_sleep(1);
        if ((++sp & 255u) == 0u) { if (xb_ld(&bar[XB_TMO])) break; if (sp > XB_SPIN_CAP) { atomicAdd(&bar[XB_TMO], 1u); break; } }
    }
    nloc = mine > 0u ? mine : 1u; nx = cnt > 0u ? cnt : 1u;
}

__device__ __forceinline__ void xcd_barrier(const XcdBarrier& b, bool leader  ) {
    asm volatile("s_waitcnt vmcnt(0)" ::: "memory");
    __syncthreads();
    if (leader) {
        unsigned* bar = b.bar;
        __builtin_amdgcn_s_waitcnt(0);
        unsigned nloc = b.st[0], nx = b.st[1];
        if (nloc == 0u) { xcd_barrier_complete(bar, b.x, nloc, nx); b.st[0] = nloc; b.st[1] = nx; }
        const unsigned old = xb_add(&bar[XB_XSUB(b.x)], 1u);
        const unsigned gen = old / nloc;
        if (old + 1u == (gen + 1u) * nloc) {
            __builtin_amdgcn_fence(__ATOMIC_RELEASE, "agent");
            asm volatile("s_waitcnt vmcnt(0)" ::: "memory");
            const unsigned og = xb_add(&bar[XB_TOP], 1u);
            const unsigned tg = og / nx;
            if (og + 1u == (tg + 1u) * nx) xb_add(&bar[XB_TOPGEN], 1u);
            else XB_SPIN(xb_ld(&bar[XB_TOPGEN]) == tg, bar);
            __builtin_amdgcn_fence(__ATOMIC_ACQUIRE, "agent");
            xb_add(&bar[XB_XGEN(b.x)], 1u);
            asm volatile("s_waitcnt vmcnt(0)" ::: "memory");
        } else {
            XB_SPIN(xb_ld(&bar[XB_XGEN(b.x)]) == gen, bar);
            __builtin_amdgcn_fence(__ATOMIC_ACQUIRE, "agent");
            asm volatile("s_waitcnt vmcnt(0)" ::: "memory");
        }
    }
    __syncthreads();
}
struct Params { const float* in[30]; float* out; unsigned char* ws; int ph_lo, ph_hi; };
enum { I_X = 0, I_C, I_CTX, I_CCTX, I_MODW, I_MODB, I_LNG, I_LNB, I_RW, I_RB, I_W1, I_W3, I_W2, I_ARE, I_AIM, I_LOGDT, I_BRE, I_BIM, I_CRE, I_CIM, I_S5D, I_WGATE, I_WVAL,
       I_SWAQKV, I_SWAO, I_SINK, I_GQAQKV, I_GQAO, I_QNORM, I_KNORM };

__device__ __forceinline__ float fold16(float (&p)[16], int lane) {
#define DPPF(x, ctrl) __builtin_bit_cast(float, __builtin_amdgcn_update_dpp(0, __builtin_bit_cast(int, (x)), (ctrl), 0xf, 0xf, false))
#pragma unroll
    for (int i = 0; i < 8; ++i) { auto r = __builtin_amdgcn_permlane32_swap(__float_as_uint(p[i]), __float_as_uint(p[i + 8]), false, false); p[i] = __uint_as_float(r[0]) + __uint_as_float(r[1]); }
#pragma unroll
    for (int i = 0; i < 4; ++i) { auto r = __builtin_amdgcn_permlane16_swap(__float_as_uint(p[i]), __float_as_uint(p[i + 4]), false, false); p[i] = __uint_as_float(r[0]) + __uint_as_float(r[1]); }
    { const bool up = (lane & 8) != 0;
#pragma unroll
      for (int i = 0; i < 2; ++i) { const float mine = up ? p[i + 2] : p[i], other = up ? p[i] : p[i + 2]; p[i] = mine + DPPF(other, 0x128); } }
    { const bool up = (lane & 4) != 0; const float mine = up ? p[1] : p[0], other = up ? p[0] : p[1]; p[0] = mine + __shfl_xor(other, 4); }
    float t = p[0]; t += DPPF(t, 0x4e); t += DPPF(t, 0xb1);
#undef DPPF
    return t;
}
__device__ __forceinline__ void ti_load(const float* __restrict__ W, int N, int k0, int n0, int lane, f32x4 (&wv)[8]) {
#pragma unroll
    for (int i = 0; i < 8; ++i) wv[i] = __builtin_nontemporal_load((const f32x4*)&W[(size_t)(k0 + 8 * i + (lane >> 3)) * N + n0 + 4 * (lane & 7)]);
}
__device__ __forceinline__ void ti_store(const f32x4 (&wv)[8], bf16* __restrict__ WT, int Kout, int out_row0, LAS float* scr, int k0, int lane) {
#pragma unroll
    for (int i = 0; i < 8; ++i) { LAS float* d = scr + (8 * i + (lane >> 3)) * 33 + 4 * (lane & 7); d[0] = wv[i][0]; d[1] = wv[i][1]; d[2] = wv[i][2]; d[3] = wv[i][3]; }
    LDS_WAIT(); asm volatile("" ::: "memory");
    const int c = lane & 7;
#pragma unroll
    for (int j = 0; j < 4; ++j) { const int n = (lane >> 3) + 8 * j; const LAS float* s = scr + (8 * c) * 33 + n;
        v4u o; o.x = pk2(s[0 * 33], s[1 * 33]); o.y = pk2(s[2 * 33], s[3 * 33]); o.z = pk2(s[4 * 33], s[5 * 33]); o.w = pk2(s[6 * 33], s[7 * 33]);
        *(v4u*)(WT + (size_t)(out_row0 + n) * Kout + k0 + 8 * c) = o; }
    LDS_WAIT(); asm volatile("" ::: "memory");
}
__device__ __forceinline__ void transpose_item(const float* __restrict__ W, int N, bf16* __restrict__ WT, int Kout, int out_row0, LAS float* scr, int k0, int n0, int lane) {
    f32x4 wv[8]; ti_load(W, N, k0, n0, lane, wv); ti_store(wv, WT, Kout, out_row0, scr, k0, lane);
}
__device__ __forceinline__ int glu_row(int n0, int second) { return (n0 >> 7) * 256 + (n0 & 127) + second * 128; }

__device__ __forceinline__ void moe_convert(const Params& P, int layer, LAS unsigned char* lds, int gw, int ngw, int wave, int lane) {
    LAS float* scr = (LAS float*)(lds + wave * 16384);
    bf16* Wup = (bf16*)(P.ws + WS_WUP); bf16* Wdn = (bf16*)(P.ws + WS_WDN);
#define CV_DEC(it_, W_, WT_, N_, Kout_, row0_, k0_, n0_) const float* W_; bf16* WT_; int N_, Kout_, row0_, k0_, n0_; { const int e_ = (it_) / 768, rr_ = (it_) % 768, which_ = rr_ >> 8, q_ = rr_ & 255; const size_t eo_ = (size_t)(layer * NEXP + e_); \
        if (which_ == 2) { const int kb_ = q_ >> 5, nb_ = q_ & 31; W_ = P.in[I_W2] + eo_ * DEXP * DM; N_ = DM; WT_ = Wdn + (size_t)e_ * DM * DEXP; Kout_ = DEXP; row0_ = 32 * nb_; k0_ = 64 * kb_; n0_ = 32 * nb_; } \
        else { const int kb_ = q_ >> 4, nb_ = q_ & 15; W_ = (which_ ? P.in[I_W3] : P.in[I_W1]) + eo_ * DM * DEXP; N_ = DEXP; WT_ = Wup + (size_t)e_ * DM * DM; Kout_ = DM; row0_ = glu_row(32 * nb_, which_); k0_ = 64 * kb_; n0_ = 32 * nb_; } }
    constexpr int TOT = NEXP * 768;
    f32x4 wa[8], wb[8];
    int it = gw;
    if (it < TOT) { CV_DEC(it, W0, T0, N0, K0, R0, k0, n0); (void)T0; (void)K0; (void)R0; ti_load(W0, N0, k0, n0, lane, wa); }
    while (it < TOT) {
        { const int itn = it + ngw; if (itn < TOT) { CV_DEC(itn, W1, T1, N1, K1, R1, k1, n1); (void)T1; (void)K1; (void)R1; ti_load(W1, N1, k1, n1, lane, wb); }
          CV_DEC(it, W0, T0, N0, K0, R0, k0, n0); (void)W0; (void)N0; (void)n0; ti_store(wa, T0, K0, R0, scr, k0, lane); it = itn; }
        if (it >= TOT) break;
        { const int itn = it + ngw; if (itn < TOT) { CV_DEC(itn, W1, T1, N1, K1, R1, k1, n1); (void)T1; (void)K1; (void)R1; ti_load(W1, N1, k1, n1, lane, wa); }
          CV_DEC(it, W0, T0, N0, K0, R0, k0, n0); (void)W0; (void)N0; (void)n0; ti_store(wb, T0, K0, R0, scr, k0, lane); it = itn; }
    }
#undef CV_DEC
}

__device__ __forceinline__ void sincos_red(float x, float& s, float& c) {
    const float n = rintf(x * 0.15915494309189535f);
    float r = fmaf(-n, 6.28125f, x); r = fmaf(-n, 1.9353071795864769e-3f, r);
    s = sinf(r); c = cosf(r);
}

__device__ __forceinline__ void phase_prologue(const Params& P, LAS unsigned char* lds, int tid, int wave, int lane) {
    const int G = gridDim.x, gw = blockIdx.x * NWAVES + wave, ngw = G * NWAVES;
    unsigned char* ws = P.ws;
    {
        LAS float* scr = (LAS float*)(lds + wave * 16384);
        constexpr int I_SQ = 16 * 32, I_QB = 16 * 40, I_QC = 16 * 48;
        constexpr int NIT = 4 * I_SQ + I_QB + I_SQ + I_QC + I_SQ;
        bf16* Wglu = (bf16*)(ws + WS_WGLU);
        for (int it = gw; it < NIT; it += ngw) {
            int r = it;
            if (r < 4 * I_SQ) { const int m = r / I_SQ, q = r % I_SQ, j = m >> 1, isgate = m & 1, kb = q >> 5, nb = q & 31;
                transpose_item(P.in[isgate ? I_WGATE : I_WVAL] + (size_t)j * DM * DM, DM, Wglu + (size_t)j * 2048 * DM, DM, glu_row(32 * nb, isgate), scr, 64 * kb, 32 * nb, lane); continue; }
            r -= 4 * I_SQ;
            if (r < I_QB) { const int kb = r / 40, nb = r % 40; transpose_item(P.in[I_SWAQKV], QKV_B, (bf16*)(ws + WS_WQKVB), DM, 32 * nb, scr, 64 * kb, 32 * nb, lane); continue; }
            r -= I_QB;
            if (r < I_SQ) { const int kb = r >> 5, nb = r & 31; transpose_item(P.in[I_SWAO], DM, (bf16*)(ws + WS_WOB), DM, 32 * nb, scr, 64 * kb, 32 * nb, lane); continue; }
            r -= I_SQ;
            if (r < I_QC) { const int kb = r / 48, nb = r % 48; transpose_item(P.in[I_GQAQKV], QKV_C, (bf16*)(ws + WS_WQKVC), DM, 32 * nb, scr, 64 * kb, 32 * nb, lane); continue; }
            r -= I_QC;
            { const int kb = r >> 5, nb = r & 31; transpose_item(P.in[I_GQAO], DM, (bf16*)(ws + WS_WOC), DM, 32 * nb, scr, 64 * kb, 32 * nb, lane); }
        }
    }
    moe_convert(P, 0, lds, gw, ngw, wave, lane);
    __syncthreads();
    {
        LAS float* sc = (LAS float*)lds; LAS float* red = (LAS float*)(lds + 16384);
        float* MOD = (float*)(ws + WS_MOD);
        for (int item = blockIdx.x; item < 4 * 96; item += G) {
            const int layer = item / 96, col0 = (item % 96) * 64;
            for (int idx = tid; idx < 3072; idx += NTHREADS) { const int c = idx >> 10, k = idx & 1023; const float v = c < 2 ? P.in[I_C][c * DM + k] : P.in[I_CCTX][k]; sc[idx] = v / (1.0f + expf(-v)); }
            __syncthreads();
            const int colq = tid & 15, kq = tid >> 4;
            float acc[3][4];
#pragma unroll
            for (int c = 0; c < 3; ++c)
#pragma unroll
                for (int j = 0; j < 4; ++j) acc[c][j] = 0.f;
            const float* wb = P.in[I_MODW] + ((size_t)layer * DM + kq * 32) * 6144 + col0 + 4 * colq;
#pragma unroll 16
            for (int kk = 0; kk < 32; ++kk) { const f32x4 w = __builtin_nontemporal_load((const f32x4*)(wb + (size_t)kk * 6144)); const int k = kq * 32 + kk;
                const float s0 = sc[k], s1 = sc[1024 + k], s2 = sc[2048 + k];
#pragma unroll
                for (int j = 0; j < 4; ++j) { acc[0][j] = fmaf(s0, w[j], acc[0][j]); acc[1][j] = fmaf(s1, w[j], acc[1][j]); acc[2][j] = fmaf(s2, w[j], acc[2][j]); } }
#pragma unroll
            for (int c = 0; c < 3; ++c)
#pragma unroll
                for (int j = 0; j < 4; ++j) red[(kq * 3 + c) * 64 + 4 * colq + j] = acc[c][j];
            __syncthreads();
            if (tid < 192) { const int c = tid >> 6, col = tid & 63; float s = 0.f;
                for (int q = 0; q < 32; ++q) s += red[(q * 3 + c) * 64 + col];
                MOD[(size_t)(layer * 3 + c) * 6144 + col0 + col] = s + P.in[I_MODB][(size_t)layer * 6144 + col0 + col]; }
            __syncthreads();
        }
    }
    {
        const int gt = blockIdx.x * NTHREADS + tid, ngt = G * NTHREADS;
        float* rope = (float*)(ws + WS_ROPE);
        for (int idx = gt; idx < 4096 + 8192; idx += ngt) {
            if (idx < 4096) { const int pos = idx >> 4, i = idx & 15; const float inv = exp2f(-(float)i * (13.287712379549449f / 16.f)); float s, c; sincos_red((float)pos * inv, s, c); rope[idx] = c; rope[4096 + idx] = s; }
            else { const int k = idx - 4096, pos = k >> 5, i = k & 31; const float inv = exp2f(-(float)i * (13.287712379549449f / 32.f)); float s, c; sincos_red((float)pos * inv, s, c); rope[8192 + k] = c; rope[16384 + k] = s; }
        }
        float* LAM = (float*)(ws + WS_LAM); float* FT = (float*)(ws + WS_FTAB);
        for (int idx = gt; idx < 256 * 64; idx += ngt) {
            const int combo = idx >> 6, p = idx & 63;
            const float are = P.in[I_ARE][combo * 64 + p], aim = P.in[I_AIM][combo * 64 + p], dt = expf(P.in[I_LOGDT][combo]);
            const float mag = expf(are * dt); float sn, cs; sincos_red(aim * dt, sn, cs);
            const float lre = mag * cs, lim = mag * sn, inv_den = 1.0f / (are * are + aim * aim), nre = lre - 1.0f;
            const float fre = (nre * are + lim * aim) * inv_den, fim = (lim * are - nre * aim) * inv_den;
            LAM[(size_t)(combo * 2 + 0) * 64 + p] = lre; LAM[(size_t)(combo * 2 + 1) * 64 + p] = lim;
            FT[(size_t)(combo * 2 + 0) * 64 + p] = fre; FT[(size_t)(combo * 2 + 1) * 64 + p] = fim;
        }
    }
}

__device__ __forceinline__ void phase_h0(const Params& P, int wave, int lane) {
    const int gw = blockIdx.x * NWAVES + wave, ngw = gridDim.x * NWAVES;
    const float* MOD = (const float*)(P.ws + WS_MOD); bf16* H = (bf16*)(P.ws + WS_H);
    constexpr int NB = 6;
    for (int row0 = gw; row0 < NR; row0 += NB * ngw) {
        f32x4 xv[NB][4];
#pragma unroll
        for (int k = 0; k < NB; ++k) { const int row = row0 + k * ngw < NR ? row0 + k * ngw : row0; const int b = row >= RPB ? 1 : 0, rr = row - b * RPB; const bool isctx = rr < NCTX;
            const float* xs = isctx ? P.in[I_CTX] + (size_t)(b * NCTX + rr) * DM : P.in[I_X] + (size_t)(b * SEQ + rr - NCTX) * DM;
#pragma unroll
            for (int j = 0; j < 4; ++j) xv[k][j] = __builtin_nontemporal_load((const f32x4*)(xs + 4 * lane + 256 * j)); }
#pragma unroll
        for (int k = 0; k < NB; ++k) { const int row = row0 + k * ngw; if (row >= NR) continue; const int b = row >= RPB ? 1 : 0, rr = row - b * RPB; const bool isctx = rr < NCTX;
            const float* mod = MOD + (size_t)(0 * 3 + (isctx ? 2 : b)) * 6144;
#pragma unroll
            for (int j = 0; j < 4; ++j) { const int col = 4 * lane + 256 * j; const f32x4 x = xv[k][j], sh = *(const f32x4*)(mod + col), sc = *(const f32x4*)(mod + 1024 + col);
                v2u o; o.x = pk2(fmaf(x[0], sc[0], x[0]) + sh[0], fmaf(x[1], sc[1], x[1]) + sh[1]); o.y = pk2(fmaf(x[2], sc[2], x[2]) + sh[2], fmaf(x[3], sc[3], x[3]) + sh[3]);
                *(v2u*)(H + (size_t)row * DM + col) = o; } }
    }
}
__device__ __forceinline__ void cpow(float lr, float li, int e, float& or_, float& oi) { float ar = 1.f, ai = 0.f; for (int k = 0; k < e; ++k) { const float t = ar * lr - ai * li; ai = ar * li + ai * lr; ar = t; } or_ = ar; oi = ai; }
__device__ __forceinline__ void phase_s5_tables(const Params& P, int tid) {
    const int gt = blockIdx.x * NTHREADS + tid, ngt = gridDim.x * NTHREADS;
    const float* LAM = (const float*)(P.ws + WS_LAM); const float* FT = (const float*)(P.ws + WS_FTAB); v4u* T = (v4u*)(P.ws + WS_S5T);
    for (int idx = gt; idx < 128 * 72 * 64; idx += ngt) {
        const int l = idx & 63, f = (idx >> 6) % 72, jg = idx / (72 * 64), j = jg >> 6, g = jg & 63, r32 = l & 31, h = l >> 5;
        float v[8];
        if (f < 32) { const int d = f >> 4, r = (f >> 2) & 3, t = f & 3, sp = t >> 1, ri = t & 1, p = sp * 32 + r32, combo = (j * 2 + d) * 64 + g;
            const float lr = LAM[(size_t)(combo * 2) * 64 + p], li = LAM[(size_t)(combo * 2 + 1) * 64 + p], fr = FT[(size_t)(combo * 2) * 64 + p], fi = FT[(size_t)(combo * 2 + 1) * 64 + p];
            float pr, pi; cpow(lr, li, d == 0 ? 3 - r : r, pr, pi); const float wr = pr * fr - pi * fi, wi = pr * fi + pi * fr;
            const float* bre = P.in[I_BRE] + ((size_t)combo * 64 + p) * 16 + 8 * h; const float* bim = P.in[I_BIM] + ((size_t)combo * 64 + p) * 16 + 8 * h;
#pragma unroll
            for (int jj = 0; jj < 8; ++jj) v[jj] = ri == 0 ? wr * bre[jj] - wi * bim[jj] : wr * bim[jj] + wi * bre[jj];
        } else if (f < 64) { const int q = f - 32, d = q >> 4, ks = (q >> 1) & 7, n = q & 1, sp = ks >> 2, ri = (ks >> 1) & 1, s_ = ks & 1, r = 2 * n + (r32 >> 4), c = r32 & 15, combo = (j * 2 + d) * 64 + g;
#pragma unroll
            for (int jj = 0; jj < 8; ++jj) { const int p = sp * 32 + 16 * s_ + 8 * h + jj;
                const float lr = LAM[(size_t)(combo * 2) * 64 + p], li = LAM[(size_t)(combo * 2 + 1) * 64 + p]; float pr, pi; cpow(lr, li, d == 0 ? r + 1 : 4 - r, pr, pi);
                const float cr = P.in[I_CRE][((size_t)combo * 16 + c) * 64 + p], ci = P.in[I_CIM][((size_t)combo * 16 + c) * 64 + p];
                v[jj] = ri == 0 ? cr * pr - ci * pi : -(cr * pi + ci * pr); }
        } else continue;
        v4u o; o.x = pk2(v[0], v[1]); o.y = pk2(v[2], v[3]); o.z = pk2(v[4], v[5]); o.w = pk2(v[6], v[7]);
        T[idx] = o;
    }
    float* KT = (float*)(P.ws + WS_KT);
    for (int idx = gt; idx < 128 * 2 * 256; idx += ngt) {
        const int cp = idx & 15, c = (idx >> 4) & 15, d = (idx >> 8) & 1, jg = idx >> 9, j = jg >> 6, g = jg & 63, combo = (j * 2 + d) * 64 + g;
        const float* lam_r = LAM + (size_t)(combo * 2) * 64; const float* lam_i = lam_r + 64; const float* f_r = FT + (size_t)(combo * 2) * 64; const float* f_i = f_r + 64;
        const float* cre = P.in[I_CRE] + ((size_t)combo * 16 + c) * 64; const float* cim = P.in[I_CIM] + ((size_t)combo * 16 + c) * 64;
        const float* bre = P.in[I_BRE] + (size_t)combo * 64 * 16 + cp; const float* bim = P.in[I_BIM] + (size_t)combo * 64 * 16 + cp;
        float acc0 = 0.f, acc1 = 0.f, acc2 = 0.f, acc3 = 0.f;
#pragma unroll 8
        for (int p = 0; p < 64; ++p) { const float lr = lam_r[p], li = lam_i[p], br = bre[p * 16], bi = bim[p * 16];
            float zr = cre[p] * f_r[p] - cim[p] * f_i[p], zi = cre[p] * f_i[p] + cim[p] * f_r[p], t_;
            acc0 += zr * br - zi * bi; t_ = zr * lr - zi * li; zi = zr * li + zi * lr; zr = t_;
            acc1 += zr * br - zi * bi; t_ = zr * lr - zi * li; zi = zr * li + zi * lr; zr = t_;
            acc2 += zr * br - zi * bi; t_ = zr * lr - zi * li; zi = zr * li + zi * lr; zr = t_;
            acc3 += zr * br - zi * bi; }
        float* kd = KT + ((size_t)jg << 11) + (d << 10) + (c << 4) + cp;
        kd[0] = acc0; kd[256] = acc1; kd[512] = acc2; kd[768] = acc3;
    }
}

#define MFMA32(a, b, c) __builtin_amdgcn_mfma_f32_32x32x16_bf16((a), (b), (c), 0, 0, 0)
template <bool REV, bool WITH_S>
__device__ __forceinline__ void s5_scan_tile(f32x16& xr, f32x16& xi, float lr, float li, float l4r, float l4i, float& cr, float& ci, int h) {
    const bool first = REV ? (h == 1) : (h == 0);
    float er[4], ei[4];
#pragma unroll
    for (int q = 0; q < 4; ++q) {
        float sr = 0.f, si = 0.f;
#pragma unroll
        for (int r = 0; r < 4; ++r) { const int reg = REV ? 15 - (4 * q + r) : 4 * q + r;
            if (r == 0) { sr = xr[reg]; si = xi[reg]; }
            else { const float nr = fmaf(lr, sr, fmaf(-li, si, xr[reg])), ni = fmaf(lr, si, fmaf(li, sr, xi[reg])); sr = nr; si = ni; } }
        er[q] = sr; ei[q] = si;
    }
    float zr = cr, zi = ci, cinr[4], cini[4];
#pragma unroll
    for (int q = 0; q < 4; ++q) {
        const auto sr_ = __builtin_amdgcn_permlane32_swap(__float_as_uint(er[q]), __float_as_uint(er[q]), false, false), si_ = __builtin_amdgcn_permlane32_swap(__float_as_uint(ei[q]), __float_as_uint(ei[q]), false, false);
        const float ar = __uint_as_float(REV ? sr_[1] : sr_[0]), ai = __uint_as_float(REV ? si_[1] : si_[0]), br = __uint_as_float(REV ? sr_[0] : sr_[1]), bi = __uint_as_float(REV ? si_[0] : si_[1]);
        const float mr = fmaf(l4r, zr, fmaf(-l4i, zi, ar)), mi = fmaf(l4r, zi, fmaf(l4i, zr, ai));
        cinr[q] = first ? zr : mr; cini[q] = first ? zi : mi;
        const float z2r = fmaf(l4r, mr, fmaf(-l4i, mi, br)), z2i = fmaf(l4r, mi, fmaf(l4i, mr, bi));
        zr = z2r; zi = z2i;
    }
    cr = zr; ci = zi;
    if constexpr (WITH_S) {
#pragma unroll
        for (int q = 0; q < 4; ++q) { float sr = cinr[q], si = cini[q];
#pragma unroll
            for (int r = 0; r < 4; ++r) { const int reg = REV ? 15 - (4 * q + r) : 4 * q + r;
                const float nr = fmaf(lr, sr, fmaf(-li, si, xr[reg])), ni = fmaf(lr, si, fmaf(li, sr, xi[reg])); sr = nr; si = ni; xr[reg] = sr; xi[reg] = si; } }
    }
}
__device__ __forceinline__ void s5_store_img(LAS unsigned char* img, const f32x16& x, int r32, int h) {
#pragma unroll
    for (int gq = 0; gq < 4; ++gq) { v2u v; v.x = pg8::cvt_pk_bf16(x[4 * gq], x[4 * gq + 1]); v.y = pg8::cvt_pk_bf16(x[4 * gq + 2], x[4 * gq + 3]);
        *(LAS v2u*)(img + r32 * 72 + 8 * (2 * gq + h)) = v; }
}
__device__ __forceinline__ void s5_read_img(unsigned base, int lane, bf16x8& a0, bf16x8& a1) {
    const int i16 = lane & 15, q = i16 >> 2, p = i16 & 3, blk = (lane >> 4) & 1, h = lane >> 5;
    const unsigned ad = base + (8 * h + q) * 72 + 8 * (4 * blk + p);
    s16x4 l0, h0, l1, h1;
    asm volatile("ds_read_b64_tr_b16 %0, %4\n\tds_read_b64_tr_b16 %1, %4 offset:288\n\tds_read_b64_tr_b16 %2, %4 offset:1152\n\tds_read_b64_tr_b16 %3, %4 offset:1440\n\ts_waitcnt lgkmcnt(0)"
                 : "=&v"(l0), "=&v"(h0), "=&v"(l1), "=&v"(h1) : "v"(ad) : "memory");
    a0 = __builtin_shufflevector(l0, h0, 0, 1, 2, 3, 4, 5, 6, 7); a1 = __builtin_shufflevector(l1, h1, 0, 1, 2, 3, 4, 5, 6, 7);
}
__device__ __forceinline__ float gelu_tanh(float x) { const float z = 0.7978845608028654f * fmaf(0.044715f * x, x * x, x); return x * pg8::sigmoidf_fast(2.0f * z); }

template <bool WITH_OUT>
__device__ __forceinline__ void s5_chunk(const Params& P, int j, int b, int c, int g, int lane, LAS unsigned char* img) {
    const int r32 = lane & 31, h = lane >> 5;
    const bf16* H = (const bf16*)(P.ws + WS_H); const int row0 = b * RPB + c * 128;
    const float* LAM = (const float*)(P.ws + WS_LAM); const bf16x8* BBF = (const bf16x8*)(P.ws + WS_BBF); const bf16x8* CMF = (const bf16x8*)(P.ws + WS_CMF);
    bf16x8 ua[4];
#pragma unroll
    for (int tb = 0; tb < 4; ++tb) ua[tb] = *(const bf16x8*)(H + (size_t)(row0 + 32 * tb + r32) * DM + 16 * g + 8 * h);
    f32x16 y[4];
    if constexpr (WITH_OUT) { const bf16x8 df = ((const bf16x8*)(P.ws + WS_DFR))[(size_t)(j * 64 + g) * 64 + lane];
#pragma unroll
        for (int tb = 0; tb < 4; ++tb) { f32x16 z = {}; y[tb] = MFMA32(ua[tb], df, z); } }
    const unsigned imgb = (unsigned)(uintptr_t)img;
#pragma unroll
    for (int dir = 0; dir < 2; ++dir) {
        const int combo = (j * 2 + dir) * 64 + g;
        float lr[2], li[2], l4r[2], l4i[2], cr[2], ci[2];
        const size_t eidx = ((size_t)((b * NCHUNK + c) * 2 + dir) * 64 + g) * 128;
#pragma unroll
        for (int sp = 0; sp < 2; ++sp) { lr[sp] = LAM[(size_t)(combo * 2 + 0) * 64 + sp * 32 + r32]; li[sp] = LAM[(size_t)(combo * 2 + 1) * 64 + sp * 32 + r32];
            const float l2r = lr[sp] * lr[sp] - li[sp] * li[sp], l2i = 2.f * lr[sp] * li[sp]; l4r[sp] = l2r * l2r - l2i * l2i; l4i[sp] = 2.f * l2r * l2i;
            if constexpr (WITH_OUT) { const float* hin = (const float*)(P.ws + WS_HIN) + eidx + sp * 64 + r32; cr[sp] = hin[0]; ci[sp] = hin[32]; } else { cr[sp] = 0.f; ci[sp] = 0.f; } }
        bf16x8 bb[4];
#pragma unroll
        for (int t = 0; t < 4; ++t) bb[t] = BBF[(size_t)(combo * 4 + t) * 64 + lane];
        bf16x8 cm[8];
        if constexpr (WITH_OUT) {
#pragma unroll
            for (int ks = 0; ks < 8; ++ks) cm[ks] = CMF[(size_t)(combo * 8 + ks) * 64 + lane]; }
#pragma unroll
        for (int tbi = 0; tbi < 4; ++tbi) {
            const int tb = dir ? 3 - tbi : tbi;
#pragma unroll
            for (int sp = 0; sp < 2; ++sp) {
                f32x16 z = {}; f32x16 xr = MFMA32(ua[tb], bb[sp * 2 + 0], z), xi = MFMA32(ua[tb], bb[sp * 2 + 1], z);
                if (dir == 0) s5_scan_tile<false, WITH_OUT>(xr, xi, lr[sp], li[sp], l4r[sp], l4i[sp], cr[sp], ci[sp], h);
                else          s5_scan_tile<true,  WITH_OUT>(xr, xi, lr[sp], li[sp], l4r[sp], l4i[sp], cr[sp], ci[sp], h);
                if constexpr (WITH_OUT) {
                    s5_store_img(img, xr, r32, h); s5_store_img(img + 2304, xi, r32, h);
                    LDS_WAIT();
                    bf16x8 a0, a1;
                    s5_read_img(imgb, lane, a0, a1);        y[tb] = MFMA32(a0, cm[sp * 4 + 0], y[tb]); y[tb] = MFMA32(a1, cm[sp * 4 + 1], y[tb]);
                    s5_read_img(imgb + 2304, lane, a0, a1); y[tb] = MFMA32(a0, cm[sp * 4 + 2], y[tb]); y[tb] = MFMA32(a1, cm[sp * 4 + 3], y[tb]);
                }
            }
        }
        if constexpr (!WITH_OUT) { if (h == 0) { float* e = (float*)(P.ws + WS_E) + eidx;
#pragma unroll
            for (int sp = 0; sp < 2; ++sp) { e[sp * 64 + r32] = cr[sp]; e[sp * 64 + 32 + r32] = ci[sp]; } } }
    }
    if constexpr (WITH_OUT) {
        bf16* G = (bf16*)(P.ws + WS_QKV);
        if (r32 < 16) {
#pragma unroll
            for (int tb = 0; tb < 4; ++tb)
#pragma unroll
                for (int r = 0; r < 16; ++r) { const int row = row0 + 32 * tb + att::crow(r, h); G[(size_t)row * DM + 16 * g + r32] = (bf16)f2bf(gelu_tanh(y[tb][r])); }
        }
    }
}
template <bool WITH_OUT>
__device__ __forceinline__ void phase_s5_chunks(const Params& P, int j, LAS unsigned char* lds, int wave, int lane) {
    LAS unsigned char* img = lds + wave * 4096;
    for (int it = blockIdx.x; it < NBATCH * NCHUNK * 8; it += gridDim.x) {
        const int go = it & 7, bc = it >> 3, b = bc / NCHUNK, c = bc % NCHUNK;
        s5_chunk<WITH_OUT>(P, j, b, c, go * 8 + wave, lane, img);
    }
}
template <bool WITH_OUT> struct S5Item { bf16x8 au[4]; float cin[2][2][2]; };
template <bool WITH_OUT>
__device__ __forceinline__ void s5v2_load(const Params& P, int b, int c, int g, int lane, S5Item<WITH_OUT>& it) {
    const int r32 = lane & 31, h = lane >> 5; const bf16* H = (const bf16*)(P.ws + WS_H); const int row0 = b * RPB + c * 128;
#pragma unroll
    for (int r = 0; r < 4; ++r) it.au[r] = *(const bf16x8*)(H + (size_t)(row0 + 4 * r32 + r) * DM + 16 * g + 8 * h);
    if constexpr (WITH_OUT) {
#pragma unroll
        for (int dir = 0; dir < 2; ++dir) { const float* hin = (const float*)(P.ws + WS_HIN) + ((size_t)((b * NCHUNK + c) * 2 + dir) * 64 + g) * 128 + r32;
#pragma unroll
            for (int sp = 0; sp < 2; ++sp) { it.cin[dir][sp][0] = hin[sp * 64]; it.cin[dir][sp][1] = hin[sp * 64 + 32]; } }
    }
}
template <bool WITH_OUT>
__device__ __forceinline__ void s5v2_chunk(const Params& P, int j, int b, int c, int g, int lane, const LAS bf16x8* tab, LAS unsigned char* img, const S5Item<WITH_OUT>& it, const float (&lm)[2][2][4]) {
    const int r32 = lane & 31, h = lane >> 5;
    const int row0 = b * RPB + c * 128;
    f32x16 y[2];
    if constexpr (WITH_OUT) {
#pragma unroll
        for (int n = 0; n < 2; ++n) { f32x16 z = {}; y[n] = z; }
        bf16x8 ft[8];
#pragma unroll
        for (int q = 0; q < 8; ++q) ft[q] = tab[(64 + q) * 64 + lane];
        att::sbar_();
#pragma unroll
        for (int rp = 0; rp < 4; ++rp)
#pragma unroll
            for (int n = 0; n < 2; ++n) y[n] = MFMA32(it.au[rp], ft[rp * 2 + n], y[n]);
        att::sbar_();
    }
    const unsigned imgb = (unsigned)(uintptr_t)img;
#pragma unroll
    for (int dir = 0; dir < 2; ++dir) {
        const size_t eidx = ((size_t)((b * NCHUNK + c) * 2 + dir) * 64 + g) * 128;
        f32x16 X[4];
#pragma unroll
        for (int t = 0; t < 4; ++t) { f32x16 z = {}; X[t] = z; }
        bf16x8 as[4];
#pragma unroll
        for (int r = 0; r < 4; ++r) {
            as[r] = it.au[r];
            if constexpr (WITH_OUT) {
                const bool ok = dir == 0 ? (r32 > 0) : (r32 < 31); const int srcl = dir == 0 ? lane - 1 : lane + 1;
                v4u w = __builtin_bit_cast(v4u, it.au[r]); w.x = (unsigned)__shfl((int)w.x, srcl); w.y = (unsigned)__shfl((int)w.y, srcl); w.z = (unsigned)__shfl((int)w.z, srcl); w.w = (unsigned)__shfl((int)w.w, srcl);
                if (!ok) { w.x = 0u; w.y = 0u; w.z = 0u; w.w = 0u; }
                as[r] = __builtin_bit_cast(bf16x8, w);
            }
        }
        {
            bf16x8 fA[4], fB[4];
#pragma unroll
            for (int t = 0; t < 4; ++t) fA[t] = tab[(dir * 16 + 0 * 4 + t) * 64 + lane];
#pragma unroll
            for (int r = 0; r < 4; ++r) {
                if (r < 3) {
#pragma unroll
                    for (int t = 0; t < 4; ++t) { if (r & 1) fA[t] = tab[(dir * 16 + (r + 1) * 4 + t) * 64 + lane]; else fB[t] = tab[(dir * 16 + (r + 1) * 4 + t) * 64 + lane]; } }
                att::sbar_();
#pragma unroll
                for (int t = 0; t < 4; ++t) X[t] = MFMA32(as[r], (r & 1) ? fB[t] : fA[t], X[t]);
                att::sbar_();
            }
        }
#pragma unroll
        for (int sp = 0; sp < 2; ++sp) {
            const float l4r = lm[dir][sp][0], l4i = lm[dir][sp][1], l16r = lm[dir][sp][2], l16i = lm[dir][sp][3];
            float cr = 0.f, ci = 0.f;
            if constexpr (WITH_OUT) {
                const float kr = it.cin[dir][sp][0], ki = it.cin[dir][sp][1];
                if (dir == 0) { X[sp * 2][0] += h == 0 ? kr : 0.f; X[sp * 2 + 1][0] += h == 0 ? ki : 0.f; }
                else          { X[sp * 2][15] += h == 1 ? kr : 0.f; X[sp * 2 + 1][15] += h == 1 ? ki : 0.f; }
                if (dir == 0) s5_scan_tile<false, true>(X[sp * 2], X[sp * 2 + 1], l4r, l4i, l16r, l16i, cr, ci, h);
                else          s5_scan_tile<true,  true>(X[sp * 2], X[sp * 2 + 1], l4r, l4i, l16r, l16i, cr, ci, h);
                bf16x8 fw[8];
#pragma unroll
                for (int q = 0; q < 8; ++q) fw[q] = tab[(32 + dir * 16 + sp * 8 + q) * 64 + lane];
                s5_store_img(img, X[sp * 2], r32, h); s5_store_img(img + 2304, X[sp * 2 + 1], r32, h);
                LDS_WAIT();
                bf16x8 a0, a1, a2, a3;
                s5_read_img(imgb, lane, a0, a1); s5_read_img(imgb + 2304, lane, a2, a3);
#pragma unroll
                for (int n = 0; n < 2; ++n) { y[n] = MFMA32(a0, fw[0 + n], y[n]); y[n] = MFMA32(a1, fw[2 + n], y[n]); y[n] = MFMA32(a2, fw[4 + n], y[n]); y[n] = MFMA32(a3, fw[6 + n], y[n]); }
            } else {
                if (dir == 0) s5_scan_tile<false, false>(X[sp * 2], X[sp * 2 + 1], l4r, l4i, l16r, l16i, cr, ci, h);
                else          s5_scan_tile<true,  false>(X[sp * 2], X[sp * 2 + 1], l4r, l4i, l16r, l16i, cr, ci, h);
                if (h == 0) { float* e = (float*)(P.ws + WS_E) + eidx; e[sp * 64 + r32] = cr; e[sp * 64 + 32 + r32] = ci; }
            }
        }
    }
    if constexpr (WITH_OUT) {
        bf16* G = (bf16*)(P.ws + WS_QKV);
#pragma unroll
        for (int n = 0; n < 2; ++n)
#pragma unroll
            for (int r = 0; r < 16; ++r) { const int row = row0 + 4 * att::crow(r, h) + 2 * n + (r32 >> 4); G[(size_t)row * DM + 16 * g + (r32 & 15)] = (bf16)f2bf(gelu_tanh(y[n][r])); }
    }
}
template <bool WITH_OUT>
__device__ __forceinline__ void phase_s5v2(const Params& P, int j, LAS unsigned char* lds, int tid, int wave, int lane) {
    const int g = ((blockIdx.x & 7) << 3) | ((blockIdx.x >> 3) & 7), q = blockIdx.x >> 6;
    auto item_bc = [&](int k, int& b, int& c) { if (k < 8) { const int o = q + 4 * k; b = o >> 4; c = 2 + 8 * (o & 15) + wave; } else { b = q >> 1; c = q & 1; } };
    S5Item<WITH_OUT> cur, nxt; int b, c; item_bc(0, b, c); s5v2_load<WITH_OUT>(P, b, c, g, lane, cur);
    LAS v4u* tabw = (LAS v4u*)lds; const v4u* src = (const v4u*)(P.ws + WS_S5T) + (size_t)(j * 64 + g) * 72 * 64;
    for (int i = tid; i < 64 * 64; i += NTHREADS) tabw[i] = src[i];
    { const float* KT = (const float*)(P.ws + WS_KT) + (size_t)(j * 64 + g) * 2048;
      const int qq = tid >> 6, l = tid & 63, rp = qq >> 1, n = qq & 1, r = 2 * n + ((l & 31) >> 4), c = l & 15, c0 = 8 * (l >> 5);
      float v[8];
      if (rp != r) { const float* k = KT + (size_t)((rp < r ? 0 : 1) * 4 + (rp < r ? r - rp : rp - r)) * 256 + c * 16 + c0;
#pragma unroll
          for (int jj = 0; jj < 8; ++jj) v[jj] = k[jj]; }
      else { const float* kf = KT + c * 16 + c0; const float* kb = KT + 4 * 256 + c * 16 + c0;
#pragma unroll
          for (int jj = 0; jj < 8; ++jj) v[jj] = kf[jj] + kb[jj] + (c == c0 + jj ? P.in[I_S5D][j * DM + 16 * g + c] : 0.f); }
      v4u o; o.x = pk2(v[0], v[1]); o.y = pk2(v[2], v[3]); o.z = pk2(v[4], v[5]); o.w = pk2(v[6], v[7]);
      tabw[(64 + qq) * 64 + l] = o; }
    float lm[2][2][4];
    { const float* LAM = (const float*)(P.ws + WS_LAM); const int r32 = lane & 31;
#pragma unroll
      for (int dir = 0; dir < 2; ++dir)
#pragma unroll
        for (int sp = 0; sp < 2; ++sp) { const int combo = (j * 2 + dir) * 64 + g;
            const float l1r = LAM[(size_t)(combo * 2 + 0) * 64 + sp * 32 + r32], l1i = LAM[(size_t)(combo * 2 + 1) * 64 + sp * 32 + r32];
            const float l2r = l1r * l1r - l1i * l1i, l2i = 2.f * l1r * l1i, l4r = l2r * l2r - l2i * l2i, l4i = 2.f * l2r * l2i;
            const float l8r = l4r * l4r - l4i * l4i, l8i = 2.f * l4r * l4i;
            lm[dir][sp][0] = l4r; lm[dir][sp][1] = l4i; lm[dir][sp][2] = l8r * l8r - l8i * l8i; lm[dir][sp][3] = 2.f * l8r * l8i; } }
    __syncthreads();
    const LAS bf16x8* tab = (const LAS bf16x8*)lds; LAS unsigned char* img = lds + 73728 + wave * 4608;
    const int nit = 8 + (wave == 0 ? 1 : 0);
    for (int k = 0; k < nit; ++k) {
        int bn = b, cn = c;
        if (k + 1 < nit) { item_bc(k + 1, bn, cn); s5v2_load<WITH_OUT>(P, bn, cn, g, lane, nxt); }
        s5v2_chunk<WITH_OUT>(P, j, b, c, g, lane, tab, img, cur, lm);
        cur = nxt; b = bn; c = cn;
    }
}
__device__ __forceinline__ void phase_s5_carry(const Params& P, int j, LAS unsigned char* lds, int tid, int wave, int lane) {
    const float* LAM = (const float*)(P.ws + WS_LAM); const float* __restrict__ E = (const float*)(P.ws + WS_E); float* __restrict__ HIN = (float*)(P.ws + WS_HIN);
    LAS float* es = (LAS float*)lds;
    for (int it = blockIdx.x; it < NBATCH * 2 * 64; it += gridDim.x) {
        const int b = it >> 7, dir = (it >> 6) & 1, g = it & 63, combo = (j * 2 + dir) * 64 + g;
        __syncthreads();
        for (int i = tid; i < NCHUNK * 32; i += NTHREADS) { const int c = i >> 5, q = i & 31;
            ((LAS f32x4*)es)[i] = *(const f32x4*)(E + ((size_t)((b * NCHUNK + c) * 2 + dir) * 64 + g) * 128 + 4 * q); }
        __syncthreads();
        if (wave == 0) {
            float pr = LAM[(size_t)(combo * 2 + 0) * 64 + lane], pi = LAM[(size_t)(combo * 2 + 1) * 64 + lane];
#pragma unroll
            for (int s_ = 0; s_ < 7; ++s_) { const float nr = pr * pr - pi * pi, ni = 2.f * pr * pi; pr = nr; pi = ni; }
            const int lo = (lane >> 5) * 64 + (lane & 31);
            float hr = 0.f, hi = 0.f;
#pragma unroll 5
            for (int s_ = 0; s_ < NCHUNK; ++s_) { const int c = dir == 0 ? s_ : (s_ < 2 ? 1 - s_ : NCHUNK + 1 - s_);
                const size_t ix = ((size_t)((b * NCHUNK + c) * 2 + dir) * 64 + g) * 128 + lo;
                HIN[ix] = hr; HIN[ix + 32] = hi;
                const float er = es[c * 128 + lo], ei = es[c * 128 + lo + 32];
                const float nr = fmaf(pr, hr, fmaf(-pi, hi, er)), ni = fmaf(pr, hi, fmaf(pi, hr, ei)); hr = nr; hi = ni; }
        }
    }
}
template <bool GLU>
__device__ __forceinline__ void ctx_gemm(const bf16* __restrict__ A, const bf16* __restrict__ Bt, int ncols_out, bf16* __restrict__ O, int ldc, LAS unsigned char* lds, int wave, int lane) {
    const int r32 = lane & 31, h = lane >> 5, nct = ncols_out >> 5, ntile = 16 * nct, kq = wave & 3, tsel = wave >> 2;
    LAS float* part = (LAS float*)lds;
    for (int t0 = blockIdx.x * 2; t0 < ntile; t0 += gridDim.x * 2) {
        const int it = t0 + tsel; const bool valid = it < ntile;
        const int rt = valid ? it / nct : 0, ct = valid ? it - rt * nct : 0, row0 = (rt >> 3) * RPB + (rt & 7) * 32, col0 = ct * 32;
        if (valid) {
            const bf16* ap = A + (size_t)(row0 + r32) * DM + 8 * h + 256 * kq;
            const bf16* bp = Bt + (size_t)((GLU ? glu_row(col0, 0) : col0) + r32) * DM + 8 * h + 256 * kq; const bf16* gp = bp + (size_t)128 * DM;
            f32x16 acc = {}, accg = {};
#pragma unroll
            for (int ks = 0; ks < 16; ++ks) { const bf16x8 a = *(const bf16x8*)(ap + 16 * ks), b = *(const bf16x8*)(bp + 16 * ks); acc = MFMA32(a, b, acc);
                if constexpr (GLU) { const bf16x8 g = *(const bf16x8*)(gp + 16 * ks); accg = MFMA32(a, g, accg); } }
            LAS float* pp = part + (size_t)((tsel * 4 + kq) * 2) * 1024 + lane;
#pragma unroll
            for (int r = 0; r < 16; ++r) { pp[r * 64] = acc[r]; if constexpr (GLU) pp[1024 + r * 64] = accg[r]; }
        }
        __syncthreads();
        if (valid) {
#pragma unroll
            for (int rr = 0; rr < 4; ++rr) { const int r = 4 * kq + rr; float v = 0.f, g = 0.f;
#pragma unroll
                for (int q = 0; q < 4; ++q) { const LAS float* pp = part + (size_t)((tsel * 4 + q) * 2) * 1024 + r * 64 + lane; v += pp[0]; if constexpr (GLU) g += pp[1024]; }
                if constexpr (GLU) v *= pg8::sigmoidf_fast(g);
                O[(size_t)(row0 + att::crow(r, h)) * ldc + col0 + r32] = (bf16)f2bf(v); }
        }
        __syncthreads();
    }
}

__device__ __forceinline__ void phase_rope_swa(const Params& P, int wave, int lane, bf16* qdummy = nullptr) {
    const int gw = blockIdx.x * NWAVES + wave, ngw = gridDim.x * NWAVES;
    bf16* QKV = (bf16*)(P.ws + WS_QKV); const float* cosB = (const float*)(P.ws + WS_ROPE); const float* sinB = cosB + 4096;
    for (int row = gw; row < NR; row += ngw) {
        const int b = row >= RPB ? 1 : 0, rr = row - b * RPB; if (rr < NCTX) continue;
        const int t = rr - NCTX; bf16* q = QKV + (size_t)row * QKV_B;
        float x1[9], x2[9], c[9], s[9];
#pragma unroll
        for (int it = 0; it < 9; ++it) { const int pi = lane + 64 * it, blk = pi >> 4, i = pi & 15, col = blk * 32 + i, pos = (blk & 1) ? (t & 63) : (t >> 6);
            c[it] = cosB[pos * 16 + i]; s[it] = sinB[pos * 16 + i]; x1[it] = bf2f(q[col]); x2[it] = bf2f(q[col + 16]); }
#pragma unroll
        for (int it = 0; it < 9; ++it) { const int pi = lane + 64 * it, blk = pi >> 4, i = pi & 15, col = blk * 32 + i;
            bf16* qo = qdummy ? qdummy + (size_t)row * QKV_B : q; qo[col] = (bf16)f2bf(x1[it] * c[it] - x2[it] * s[it]); qo[col + 16] = (bf16)f2bf(x2[it] * c[it] + x1[it] * s[it]); }
    }
}
__device__ __forceinline__ void phase_normrope_gqa(const Params& P, int wave, int lane, bf16* qdummy = nullptr) {
    const int gw = blockIdx.x * NWAVES + wave, ngw = gridDim.x * NWAVES;
    bf16* QKV = (bf16*)(P.ws + WS_QKV); const float* cosC = (const float*)(P.ws + WS_ROPE) + 8192; const float* sinC = cosC + 8192;
    const int a = lane >> 5, i = lane & 31, d1 = a * 64 + i, d2 = d1 + 32;
    const float gk1 = P.in[I_KNORM][d1], gk2 = P.in[I_KNORM][d2];
    constexpr int NB = 11;
    for (int it0 = gw; it0 < NR * 2; it0 += NB * ngw) {
        float x1[NB], x2[NB], c[NB], s[NB];
#pragma unroll
        for (int k = 0; k < NB; ++k) { const int it = it0 + k * ngw < NR * 2 ? it0 + k * ngw : it0; const int row = it >> 1, hd = 8 + (it & 1);
            const int b = row >= RPB ? 1 : 0, rr = row - b * RPB; const bool lat = rr >= NCTX; const int t = rr - NCTX;
            c[k] = 1.f; s[k] = 0.f;
            if (lat) { const int pos = a ? (t & 63) : (t >> 6); c[k] = cosC[pos * 32 + i]; s[k] = sinC[pos * 32 + i]; }
            const bf16* q = QKV + (size_t)row * QKV_C + hd * 128; x1[k] = bf2f(q[d1]); x2[k] = bf2f(q[d2]); }
#pragma unroll
        for (int k = 0; k < NB; ++k) { const int it = it0 + k * ngw; const bool ok = it < NR * 2; const int itc = ok ? it : it0, row = itc >> 1, hd = 8 + (itc & 1);
            bf16* qo = (qdummy ? qdummy : QKV) + (size_t)row * QKV_C + hd * 128;
            const float ss = wave_sum(x1[k] * x1[k] + x2[k] * x2[k]), rstd = 1.0f / sqrtf(ss * (1.0f / 128.f) + RMS_EPS);
            const float n1 = x1[k] * rstd * gk1, n2 = x2[k] * rstd * gk2;
            if (ok) { qo[d1] = (bf16)f2bf(n1 * c[k] - n2 * s[k]); qo[d2] = (bf16)f2bf(n2 * c[k] + n1 * s[k]); } }
    }
}

__device__ __forceinline__ int vt_key(int pos) { const int ks = pos >> 4, h = (pos >> 3) & 1, e = pos & 7; return 32 * (ks >> 1) + 16 * (ks & 1) + 8 * (e >> 2) + 4 * h + (e & 3); }
__device__ __forceinline__ void phase_vt_gqa(const Params& P, LAS unsigned char* lds, int wave, int lane) {
    if (wave >= 7) return;
    const int gw = blockIdx.x * 7 + wave, ngw = gridDim.x * 7;
    const bf16* QKV = (const bf16*)(P.ws + WS_QKV); bf16* VT = (bf16*)(P.ws + WS_VT);
    LAS unsigned short* T = (LAS unsigned short*)(lds + wave * 16640);
    for (int it = gw; it < NBATCH * 2 * (RPB / 64); it += ngw) {
        const int j = it % (RPB / 64), bk = it / (RPB / 64), b = bk >> 1, kvh = bk & 1;
        const bf16* src = QKV + ((size_t)b * RPB + 64 * j) * QKV_C + 1280 + kvh * 128;
        v4u vv[16];
#pragma unroll
        for (int i = 0; i < 16; ++i) { const int chunk = i * 64 + lane, key = chunk >> 4, c = chunk & 15; vv[i] = __builtin_nontemporal_load((const v4u*)(src + (size_t)key * QKV_C + 8 * c)); }
#pragma unroll
        for (int i = 0; i < 16; ++i) { const int chunk = i * 64 + lane, key = chunk >> 4, c = chunk & 15;
            LAS unsigned* d = (LAS unsigned*)(T + key * 130 + 8 * c); d[0] = vv[i].x; d[1] = vv[i].y; d[2] = vv[i].z; d[3] = vv[i].w; }
        LDS_WAIT(); asm volatile("" ::: "memory");
        bf16* dst = VT + ((size_t)bk * 128) * RPB + 64 * j;
        const int dl = lane >> 3, c = lane & 7;
#pragma unroll 4
        for (int i = 0; i < 16; ++i) { const int d = 8 * i + dl; unsigned w[4];
#pragma unroll
            for (int e = 0; e < 4; ++e) { const unsigned lo = T[vt_key(8 * c + 2 * e) * 130 + d], hi = T[vt_key(8 * c + 2 * e + 1) * 130 + d]; w[e] = lo | (hi << 16); }
            v4u o; o.x = w[0]; o.y = w[1]; o.z = w[2]; o.w = w[3]; *(v4u*)(dst + (size_t)d * RPB + 8 * c) = o; }
        LDS_WAIT(); asm volatile("" ::: "memory");
    }
}

__device__ __forceinline__ void phase_attn_swa(const Params& P, LAS unsigned char* lds, int tid_in) {
    const bf16* QKV = (const bf16*)(P.ws + WS_QKV); bf16* O = (bf16*)(P.ws + WS_O);
    for (int u = blockIdx.x; u < 2048 + 32; u += gridDim.x) {
        int h, b, qb, nt; size_t rq;
        if (u < 2048) { h = u & 15; qb = (u >> 4) & 63; b = u >> 10; nt = 12; rq = (size_t)b * RPB + NCTX + qb * 256; }
        else { const int v = u - 2048; h = v & 15; b = v >> 4; qb = 0; nt = 4; rq = (size_t)b * RPB; }
        const int kvh = h >> 3; const size_t r0 = (size_t)b * RPB;
        att::attn_unit<64, true, QKV_B, QKV_B, DM, SEQ>(QKV + rq * QKV_B + h * 64, QKV + r0 * QKV_B + 1024 + kvh * 64, QKV + r0 * QKV_B + 1152 + kvh * 64,
                                                        O + rq * DM + h * 64, nt, qb * 256, true, P.in[I_SINK][h], (char*)lds, tid_in);
    }
}
__device__ __forceinline__ void phase_attn_gqa(const Params& P, LAS unsigned char* lds, int tid_in) {
    const bf16* QKV = (const bf16*)(P.ws + WS_QKV); bf16* O = (bf16*)(P.ws + WS_O);
    bool nomax;
    { const int l = hw_lane(); float mq = fmaxf(fabsf(P.in[I_QNORM][l]), fabsf(P.in[I_QNORM][64 + l])), mk = fmaxf(fabsf(P.in[I_KNORM][l]), fabsf(P.in[I_KNORM][64 + l]));
#pragma unroll
      for (int o = 1; o < 64; o <<= 1) { mq = fmaxf(mq, __shfl_xor(mq, o)); mk = fmaxf(mk, __shfl_xor(mk, o)); }
      nomax = __builtin_amdgcn_readfirstlane((11.313708498984761f * 1.03f * mq * mk < 40.f) ? 1 : 0) != 0; }
    for (int u = blockIdx.x; u < 1024 + 16; u += gridDim.x) {
        int h, b, nt; size_t rq;
        if (u < 1024) { const int bk = u >> 8, rem = u & 255; b = bk >> 1; h = (bk & 1) * 4 + (rem >> 6); nt = RPB / 64; rq = (size_t)b * RPB + NCTX + (rem & 63) * 256; }
        else { const int v = u - 1024; h = v & 7; b = v >> 3; nt = 4; rq = (size_t)b * RPB; }
        const int kvh = h >> 2; const size_t r0 = (size_t)b * RPB;
        const float* cosC = (const float*)(P.ws + WS_ROPE) + 8192; const int tq0 = u < 1024 ? (int)(rq - r0) - NCTX : -1;
        if (nomax) att::attn_unit<128, false, QKV_C, QKV_C, DM, SEQ, true, true>(QKV + rq * QKV_C + h * 128, QKV + r0 * QKV_C + 1024 + kvh * 128, QKV + r0 * QKV_C + 1280 + kvh * 128,
                                                                               O + rq * DM + h * 128, nt, 0, false, 0.f, (char*)lds, tid_in, P.in[I_QNORM], cosC, cosC + 8192, tq0,
                                                                               (const bf16*)(P.ws + WS_VT) + (size_t)((b * 2 + kvh) * 128) * RPB, RPB);
        else       att::attn_unit<128, false, QKV_C, QKV_C, DM, SEQ, false, true>(QKV + rq * QKV_C + h * 128, QKV + r0 * QKV_C + 1024 + kvh * 128, QKV + r0 * QKV_C + 1280 + kvh * 128,
                                                                                O + rq * DM + h * 128, nt, 0, false, 0.f, (char*)lds, tid_in, P.in[I_QNORM], cosC, cosC + 8192, tq0);
    }
}

__device__ __forceinline__ void phase_ln1(const Params& P, int layer, LAS unsigned char* lds, int tid, int wave, int lane, float* xdummy = nullptr) {
    constexpr int RWS = DM + 4;
    LAS float* rwT = (LAS float*)lds; LAS int* cnt = (LAS int*)(lds + 66048); LAS float* lg = (LAS float*)(lds + 66048 + 256) + wave * 32;
    const int vb = blockIdx.x;
    const float* MOD = (const float*)(P.ws + WS_MOD); bf16* H = (bf16*)(P.ws + WS_H); const bf16* Y = (const bf16*)(P.ws + WS_Y);
    bf16* X = (bf16*)(P.ws + WS_X); unsigned* ROUTE = (unsigned*)(P.ws + WS_ROUTE);
    const float* lng = P.in[I_LNG] + (size_t)(layer * 2 + 0) * DM; const float* lnb = P.in[I_LNB] + (size_t)(layer * 2 + 0) * DM;
    auto xload = [&](int row, f32x4 (&xo)[4]) { const int b = row >= RPB ? 1 : 0, rr = row - b * RPB;
        if (layer == 0) { const float* xs = rr < NCTX ? P.in[I_CTX] + (size_t)(b * NCTX + rr) * DM : P.in[I_X] + (size_t)(b * SEQ + rr - NCTX) * DM;
#pragma unroll
            for (int j = 0; j < 4; ++j) xo[j] = __builtin_nontemporal_load((const f32x4*)(xs + 4 * lane + 256 * j)); }
        else {
#pragma unroll
            for (int j = 0; j < 4; ++j) { const v2u w = __builtin_nontemporal_load((const v2u*)(X + (size_t)row * DM + 4 * lane + 256 * j)); xo[j] = (f32x4){bflo(w.x), bfhi(w.x), bflo(w.y), bfhi(w.y)}; } } };
    f32x4 xn_[4]; v2u yn_[4];
    { const int row = vb * 130 + wave; xload(row, xn_);
#pragma unroll
      for (int j = 0; j < 4; ++j) yn_[j] = __builtin_nontemporal_load((const v2u*)(Y + (size_t)row * DM + 4 * lane + 256 * j)); }
    for (int idx = tid; idx < DM * NEXP; idx += NTHREADS) rwT[(idx & 15) * RWS + (idx >> 4)] = P.in[I_RW][idx];
    LAS float* cv = (LAS float*)(lds + 69632);
    for (int i = tid; i < 11 * 1024 + NEXP; i += NTHREADS) { const int v = i >> 10, col = i & 1023;
        cv[i] = v < 9 ? MOD[(size_t)(layer * 3 + v / 3) * 6144 + 2048 + (v % 3) * 1024 + col] : (v == 9 ? lng[col] : (v == 10 ? lnb[col] : P.in[I_RB][col])); }
    if (tid < NEXP) cnt[tid] = 0;
    __syncthreads();
    auto ln_row = [&](int ri, f32x4 (&hv)[4]) {
        const int row = vb * 130 + ri, b = row >= RPB ? 1 : 0, rr = row - b * RPB; const bool isctx = rr < NCTX;
        bf16* xd = xdummy ? (bf16*)xdummy + (size_t)row * DM : X + (size_t)row * DM;
        const LAS float* cvm = cv + (isctx ? 2 : b) * 3072;
        f32x4 v[4]; float s = 0.f;
#pragma unroll
        for (int j = 0; j < 4; ++j) { const int col = 4 * lane + 256 * j; const f32x4 x = xn_[j], gt = *(const LAS f32x4*)(cvm + col); const v2u yy = yn_[j];
            v[j][0] = fmaf(ALPHA, x[0], gt[0] * bflo(yy.x)); v[j][1] = fmaf(ALPHA, x[1], gt[1] * bfhi(yy.x)); v[j][2] = fmaf(ALPHA, x[2], gt[2] * bflo(yy.y)); v[j][3] = fmaf(ALPHA, x[3], gt[3] * bfhi(yy.y));
            s += (v[j][0] + v[j][1]) + (v[j][2] + v[j][3]); }
        if (ri + 8 < 130) { const int rown = row + 8; xload(rown, xn_);
#pragma unroll
            for (int j = 0; j < 4; ++j) yn_[j] = __builtin_nontemporal_load((const v2u*)(Y + (size_t)rown * DM + 4 * lane + 256 * j)); }
        const float mean = wave_sum(s) * (1.f / DM); float s2 = 0.f;
#pragma unroll
        for (int j = 0; j < 4; ++j) { v[j] = v[j] - mean; s2 += (v[j][0] * v[j][0] + v[j][1] * v[j][1]) + (v[j][2] * v[j][2] + v[j][3] * v[j][3]); }
        const float rstd = 1.0f / sqrtf(wave_sum(s2) * (1.f / DM) + LN_EPS);
#pragma unroll
        for (int j = 0; j < 4; ++j) { const int col = 4 * lane + 256 * j; const f32x4 lgv = *(const LAS f32x4*)(cv + 9216 + col), lbv = *(const LAS f32x4*)(cv + 10240 + col), shv = *(const LAS f32x4*)(cvm + 1024 + col), scv = *(const LAS f32x4*)(cvm + 2048 + col);
            f32x4 xn = v[j] * rstd * lgv + lbv; f32x4 h2 = xn * scv + xn + shv; hv[j] = h2; v[j] = xn; }
#pragma unroll
        for (int j = 0; j < 4; ++j) { const int col = 4 * lane + 256 * j; v2u xo; xo.x = pk2(v[j][0], v[j][1]); xo.y = pk2(v[j][2], v[j][3]); __builtin_nontemporal_store(xo, (v2u*)(xd + col));
            v2u o; o.x = pk2(hv[j][0], hv[j][1]); o.y = pk2(hv[j][2], hv[j][3]); *(v2u*)(H + (size_t)row * DM + col) = o; }
    };
    for (int k = 0; k < 17; k += 2) {
        const int ri0 = wave + 8 * k, ri1 = ri0 + 8; if (ri0 >= 130) break;
        const bool two = ri1 < 130;
        f32x4 hvA[4], hvB[4];
        ln_row(ri0, hvA);
        asm volatile("" ::: "memory");
        if (two) ln_row(ri1, hvB); else {
#pragma unroll
            for (int j = 0; j < 4; ++j) hvB[j] = hvA[j]; }
        asm volatile("" ::: "memory");
        float pA[NEXP], pB[NEXP];
#define LN1_ROUTER(TWO_) do { _Pragma("unroll") for (int e = 0; e < NEXP; ++e) { pg8::f32x2 qa = {0.f, 0.f}, qb = {0.f, 0.f}; \
            _Pragma("unroll") for (int j = 0; j < 4; ++j) { const f32x4 w = *(const LAS f32x4*)(rwT + e * RWS + 4 * lane + 256 * j); \
                const pg8::f32x2 w01 = {w[0], w[1]}, w23 = {w[2], w[3]}; \
                qa = __builtin_elementwise_fma((pg8::f32x2){hvA[j][0], hvA[j][1]}, w01, qa); qa = __builtin_elementwise_fma((pg8::f32x2){hvA[j][2], hvA[j][3]}, w23, qa); \
                if (TWO_) { qb = __builtin_elementwise_fma((pg8::f32x2){hvB[j][0], hvB[j][1]}, w01, qb); qb = __builtin_elementwise_fma((pg8::f32x2){hvB[j][2], hvB[j][3]}, w23, qb); } } \
            pA[e] = qa.x + qa.y; pB[e] = qb.x + qb.y; \
            if (e & 1) asm volatile("" ::: "memory"); } } while (0)
        float ta, tb = 0.f;
        if (two) { LN1_ROUTER(true); ta = fold16(pA, lane); tb = fold16(pB, lane); } else { LN1_ROUTER(false); ta = fold16(pA, lane); }
#undef LN1_ROUTER
        { if ((lane & 3) == 0) { const int ei = 8 * ((lane >> 5) & 1) + 4 * ((lane >> 4) & 1) + 2 * ((lane >> 3) & 1) + ((lane >> 2) & 1); lg[ei] = ta; lg[16 + ei] = tb; } }
        LDS_WAIT(); asm volatile("" ::: "memory");
        {
            const int r = lane & 1;
            const int row = vb * 130 + ri0 + 8 * r;
            float aff[NEXP], sel[NEXP];
#pragma unroll
            for (int q = 0; q < 4; ++q) { const f32x4 t = *(const LAS f32x4*)(lg + r * 16 + 4 * q);
#pragma unroll
                for (int i = 0; i < 4; ++i) { aff[4 * q + i] = __builtin_amdgcn_rcpf(1.0f + __builtin_amdgcn_exp2f(-1.4426950408889634f * t[i])); sel[4 * q + i] = aff[4 * q + i] + cv[11264 + 4 * q + i]; } }
            float bestgs = 0.f; int bg = 0;
#pragma unroll
            for (int gi = 0; gi < 4; ++gi) { const float s0 = sel[4 * gi], s1 = sel[4 * gi + 1], s2_ = sel[4 * gi + 2], s3 = sel[4 * gi + 3];
                const float gs = fmaxf(fmaxf(fmaxf(s0 + s1, s0 + s2_), fmaxf(s0 + s3, s1 + s2_)), fmaxf(s1 + s3, s2_ + s3));
                if (gi == 0 || gs > bestgs) { bestgs = gs; bg = gi; } }
            float a0 = aff[0], a1 = aff[1], a2 = aff[2], a3 = aff[3], q0 = sel[0], q1 = sel[1], q2 = sel[2], q3 = sel[3];
#pragma unroll
            for (int gi = 1; gi < 4; ++gi) if (bg == gi) { a0 = aff[4 * gi]; a1 = aff[4 * gi + 1]; a2 = aff[4 * gi + 2]; a3 = aff[4 * gi + 3]; q0 = sel[4 * gi]; q1 = sel[4 * gi + 1]; q2 = sel[4 * gi + 2]; q3 = sel[4 * gi + 3]; }
            int i0 = 0; float m0 = q0, g0 = a0;
            if (q1 > m0) { m0 = q1; i0 = 1; g0 = a1; } if (q2 > m0) { m0 = q2; i0 = 2; g0 = a2; } if (q3 > m0) { m0 = q3; i0 = 3; g0 = a3; }
            int i1 = -1; float m1 = 0.f, g1 = 0.f;
            if (i0 != 0) { m1 = q0; i1 = 0; g1 = a0; }
            if (i0 != 1 && (i1 < 0 || q1 > m1)) { m1 = q1; i1 = 1; g1 = a1; }
            if (i0 != 2 && (i1 < 0 || q2 > m1)) { m1 = q2; i1 = 2; g1 = a2; }
            if (i0 != 3 && (i1 < 0 || q3 > m1)) { m1 = q3; i1 = 3; g1 = a3; }
            const float inv = 1.0f / (g0 + g1);
            if (lane < (two ? 2 : 1)) { const int e0 = 4 * bg + i0, e1 = 4 * bg + i1; unsigned* rt = ROUTE + (size_t)row * 8;
                rt[0] = (unsigned)e0; rt[1] = (unsigned)e1; rt[2] = __float_as_uint(g0 * inv); rt[3] = __float_as_uint(g1 * inv);
                __hip_atomic_fetch_add(&cnt[e0], 1, __ATOMIC_RELAXED, __HIP_MEMORY_SCOPE_WORKGROUP); __hip_atomic_fetch_add(&cnt[e1], 1, __ATOMIC_RELAXED, __HIP_MEMORY_SCOPE_WORKGROUP); }
        }
        LDS_WAIT(); asm volatile("" ::: "memory");
    }
    __syncthreads();
    if (tid < NEXP) ((int*)(P.ws + WS_CNTB))[vb * NEXP + tid] = cnt[tid];
}
__device__ __forceinline__ void phase_dispatch(const Params& P, LAS unsigned char* lds, int tid, int wave, int lane) {
    LAS int* cl = (LAS int*)lds;
    LAS int* tot = cl + NGRID * NEXP; LAS int* base = tot + 16; LAS int* ent = tot + 64;
    LAS float* gts = (LAS float*)(ent + 320);
    const int vb = blockIdx.x; const int* cntb = (const int*)(P.ws + WS_CNTB);
    unsigned* ROUTE = (unsigned*)(P.ws + WS_ROUTE); int* pane = (int*)(P.ws + WS_PANE);
    for (int i = tid; i < NGRID * NEXP; i += NTHREADS) cl[i] = cntb[i];
    if (tid < 260) { const unsigned* rt = ROUTE + (size_t)(vb * 130 + (tid >> 1)) * 8; ent[tid] = (int)rt[tid & 1]; gts[tid] = __uint_as_float(rt[2 + (tid & 1)]); }
    __syncthreads();
    { LAS int* part = ent + 1024;
      const int e = tid & 15, pt = tid >> 4; int t = 0, bf = 0;
#pragma unroll
      for (int k = 0; k < 8; ++k) { const int b2 = 8 * pt + k, c = cl[b2 * NEXP + e]; t += c; bf += b2 < vb ? c : 0; }
      part[pt * 16 + e] = t; part[512 + pt * 16 + e] = bf; }
    __syncthreads();
    if (tid < NEXP) { LAS int* part = ent + 1024; int t = 0, bf = 0;
#pragma unroll
        for (int pt = 0; pt < 32; ++pt) { t += part[pt * 16 + tid]; bf += part[512 + pt * 16 + tid]; } tot[tid] = t; base[tid] = bf; }
    __syncthreads();
    if (wave == 0) {
        int off = 0, mybase = 0;
        for (int e = 0; e < NEXP; ++e) { const int np = (tot[e] + 255) >> 8; if (lane == e) mybase = off + base[e];
            if (vb == 0) for (int p = lane; p < np; p += 64) pane[16 + (off >> 8) + p] = e;
            off += np << 8; }
        if (vb == 0 && lane == 0) pane[0] = off >> 8;
        for (int q = 0; q < 5; ++q) { const int i = q * 64 + lane; const bool act = i < 260; const int me = act ? ent[i] : -1; int mypos = 0;
#pragma unroll
            for (int e = 0; e < NEXP; ++e) { const unsigned long long mk = __ballot(me == e); const int be = __shfl(mybase, e);
                if (me == e) mypos = be + __popcll(mk & ((1ull << lane) - 1ull));
                if (lane == e) mybase += __popcll(mk); }
            if (act) { ent[i] = mypos; ROUTE[(size_t)(vb * 130 + (i >> 1)) * 8 + 4 + (i & 1)] = (unsigned)mypos; } }
    }
    __syncthreads();
    float* gs = (float*)(P.ws + WS_GSLOT); int* rowmap = (int*)(P.ws + WS_ROWMAP);
    if (tid < 260) { const int p = ent[tid]; rowmap[p] = vb * 130 + (tid >> 1); gs[p] = gts[tid]; }
    if (vb == 0) {
        int off = 0;
        for (int e = 0; e < NEXP; ++e) { const int t = tot[e], np = (t + 255) >> 8; for (int p = t + tid; p < (np << 8); p += NTHREADS) rowmap[off + p] = 0; off += np << 8; }
    }
}
__device__ __forceinline__ void phase_ln2(const Params& P, int layer, int wave, int lane, float* xdummy = nullptr) {
    const int gw = blockIdx.x * NWAVES + wave, ngw = gridDim.x * NWAVES;
    const float* MOD = (const float*)(P.ws + WS_MOD); bf16* H = (bf16*)(P.ws + WS_H); const bf16* YS = (const bf16*)(P.ws + WS_HS);
    bf16* X = (bf16*)(P.ws + WS_X); const unsigned* ROUTE = (const unsigned*)(P.ws + WS_ROUTE);
    const float* lng = P.in[I_LNG] + (size_t)(layer * 2 + 1) * DM; const float* lnb = P.in[I_LNB] + (size_t)(layer * 2 + 1) * DM;
    constexpr int NRW = 6;
    unsigned pn0[NRW], pn1[NRW];
#pragma unroll
    for (int r = 0; r < NRW; ++r) { const int rw = gw + r * ngw; const unsigned* rt = ROUTE + (size_t)(rw < NR ? rw : gw) * 8; pn0[r] = rt[4]; pn1[r] = rt[5]; }
    for (int row0 = gw; row0 < NR; row0 += NRW * ngw) {
        int row[NRW]; bool ok[NRW]; v4u xw[NRW][2], ya[NRW][2], yb[NRW][2];
#pragma unroll
        for (int r = 0; r < NRW; ++r) { ok[r] = row0 + r * ngw < NR; row[r] = ok[r] ? row0 + r * ngw : row0;
            const bf16* xr = X + (size_t)row[r] * DM + 8 * lane; const bf16* y0 = YS + (size_t)pn0[r] * DM + 8 * lane; const bf16* y1 = YS + (size_t)pn1[r] * DM + 8 * lane;
#pragma unroll
            for (int c = 0; c < 2; ++c) { xw[r][c] = __builtin_nontemporal_load((const v4u*)(xr + 512 * c)); ya[r][c] = __builtin_nontemporal_load((const v4u*)(y0 + 512 * c)); yb[r][c] = __builtin_nontemporal_load((const v4u*)(y1 + 512 * c)); } }
#pragma unroll
        for (int r = 0; r < NRW; ++r) { const int rw = row0 + (NRW + r) * ngw; const unsigned* rt = ROUTE + (size_t)(rw < NR ? rw : gw) * 8; pn0[r] = rt[4]; pn1[r] = rt[5]; }
        f32x4 lgv[4], lbv[4];
#pragma unroll
        for (int c = 0; c < 2; ++c)
#pragma unroll
            for (int q = 0; q < 2; ++q) { const int col = 8 * lane + 512 * c + 4 * q; lgv[2 * c + q] = *(const f32x4*)(lng + col); lbv[2 * c + q] = *(const f32x4*)(lnb + col); }
#pragma unroll
        for (int r = 0; r < NRW; ++r) {
            if (!ok[r]) continue;
            const int b = row[r] >= RPB ? 1 : 0, rr = row[r] - b * RPB, cond = rr < NCTX ? 2 : b;
            const float* mod = MOD + (size_t)(layer * 3 + cond) * 6144; const float* modn = MOD + (size_t)((layer < 3 ? layer + 1 : 3) * 3 + cond) * 6144;
            f32x4 v[4]; float s = 0.f;
#pragma unroll
            for (int c = 0; c < 2; ++c)
#pragma unroll
                for (int q = 0; q < 2; ++q) { const int col = 8 * lane + 512 * c + 4 * q; const f32x4 gt = *(const f32x4*)(mod + 5120 + col);
                    const unsigned x0 = xw[r][c][2 * q], x1 = xw[r][c][2 * q + 1], a0 = ya[r][c][2 * q], a1 = ya[r][c][2 * q + 1], b0 = yb[r][c][2 * q], b1 = yb[r][c][2 * q + 1];
                    f32x4& o = v[2 * c + q];
                    o[0] = fmaf(ALPHA, bflo(x0), gt[0] * (bflo(a0) + bflo(b0))); o[1] = fmaf(ALPHA, bfhi(x0), gt[1] * (bfhi(a0) + bfhi(b0)));
                    o[2] = fmaf(ALPHA, bflo(x1), gt[2] * (bflo(a1) + bflo(b1))); o[3] = fmaf(ALPHA, bfhi(x1), gt[3] * (bfhi(a1) + bfhi(b1)));
                    s += (o[0] + o[1]) + (o[2] + o[3]); }
            const float mean = wave_sum(s) * (1.f / DM); float s2 = 0.f;
#pragma unroll
            for (int k = 0; k < 4; ++k) { v[k] = v[k] - mean; s2 += (v[k][0] * v[k][0] + v[k][1] * v[k][1]) + (v[k][2] * v[k][2] + v[k][3] * v[k][3]); }
            const float rstd = 1.0f / sqrtf(wave_sum(s2) * (1.f / DM) + LN_EPS);
            f32x4 xn[4];
#pragma unroll
            for (int k = 0; k < 4; ++k) xn[k] = v[k] * rstd * lgv[k] + lbv[k];
            if (layer == 3) {
                if (rr >= NCTX) { float* xf = (xdummy ? xdummy + (size_t)row[r] * DM : P.out + (size_t)(b * SEQ + rr - NCTX) * DM) + 8 * lane;
#pragma unroll
                    for (int c = 0; c < 2; ++c) { __builtin_nontemporal_store(xn[2 * c], (f32x4*)(xf + 512 * c)); __builtin_nontemporal_store(xn[2 * c + 1], (f32x4*)(xf + 512 * c + 4)); } }
            } else {
                bf16* xd = (xdummy ? (bf16*)xdummy : X) + (size_t)row[r] * DM + 8 * lane; bf16* hd = H + (size_t)row[r] * DM + 8 * lane;
#pragma unroll
                for (int c = 0; c < 2; ++c) { v4u xo, ho;
#pragma unroll
                    for (int q = 0; q < 2; ++q) { const int col = 8 * lane + 512 * c + 4 * q; const f32x4 sh = *(const f32x4*)(modn + col), sc = *(const f32x4*)(modn + 1024 + col);
                        const f32x4 xx = xn[2 * c + q], hv = xx * sc + xx + sh;
                        xo[2 * q] = pk2(xx[0], xx[1]); xo[2 * q + 1] = pk2(xx[2], xx[3]); ho[2 * q] = pk2(hv[0], hv[1]); ho[2 * q + 1] = pk2(hv[2], hv[3]); }
                    __builtin_nontemporal_store(xo, (v4u*)(xd + 512 * c)); *(v4u*)(hd + 512 * c) = ho; }
            }
        }
    }
}

#ifndef PHSEL
#define PHSEL -1
#endif
#ifndef PROBE_GROUP
#define PROBE_GROUP 0
#endif
#define IN(k) ((PHSEL < 0 || PHSEL == (k)) && lo <= (k) && (k) < hi)
#define SEAM(k) do { if (IN(k) && IN((k) + 1)) { xcd_barrier(bar, HW_TID(wave0) == 0); if (PROBE_GROUP == 6) xcd_barrier(bar, HW_TID(wave0) == 0); } } while (0)
#define REP(g) for (int rep_ = 0; rep_ < ((PROBE_GROUP == (g)) ? 2 : 1); ++rep_)
#define LAUNDER() int tid = HW_TID(wave0); asm volatile("" : "+v"(tid)); const int lane = tid & 63, wave = __builtin_amdgcn_readfirstlane(tid >> 6); (void)lane; (void)wave
typedef pg8::EpiBf16<0> EpiPlain;
template <int LAYER>
__device__ __forceinline__ void run_layer(const Params& P, LAS unsigned char* lds, const XcdBarrier& bar, int lo, int hi, int wave0) {
    constexpr int pb = 2 + 9 * LAYER, kind = LAYER % 3, j = LAYER / 3;
    const int G = gridDim.x;
    if constexpr (kind == 0) {
        if (IN(pb + 0)) { LAUNDER(); if (LAYER > 0) REP(5) { moe_convert(P, LAYER, lds, blockIdx.x * NWAVES + wave, G * NWAVES, wave, lane); __syncthreads(); }
                          phase_s5v2<false>(P, j, lds, tid, wave, lane); __syncthreads(); SEAM(pb + 0); }
        if (IN(pb + 1)) { LAUNDER(); phase_s5_carry(P, j, lds, tid, wave, lane); SEAM(pb + 1); }
        if (IN(pb + 2)) { LAUNDER(); phase_s5v2<true>(P, j, lds, tid, wave, lane); __syncthreads(); SEAM(pb + 2); }
        if (IN(pb + 3)) { if (LAYER < 3) { LAUNDER(); ctx_gemm<true>((const bf16*)(P.ws + WS_QKV), (const bf16*)(P.ws + WS_WGLU) + (size_t)j * 2048 * DM, DM, (bf16*)(P.ws + WS_Y), DM, lds, wave, lane); }
                          pg8::Gemm g{(const bf16*)(P.ws + WS_QKV), (const bf16*)(P.ws + WS_WGLU) + (size_t)j * 2048 * DM, NR, 2048, DM, nullptr, 0}; pg8::LatOrder S; S.init(2048, G, (int)blockIdx.x);
                          pg8::EpiGlu E{(bf16*)(P.ws + WS_Y), DM}; REP(4) { pg8::gemm_phase<pg8::EpiGlu, pg8::LatOrder, true, true>(lds, g, S, E, HW_TID(wave0)); } SEAM(pb + 3); }
    } else if constexpr (kind == 1) {
        if (IN(pb + 0)) { { LAUNDER(); REP(5) { moe_convert(P, LAYER, lds, blockIdx.x * NWAVES + wave, G * NWAVES, wave, lane); __syncthreads(); } }
                          { LAUNDER(); ctx_gemm<false>((const bf16*)(P.ws + WS_H), (const bf16*)(P.ws + WS_WQKVB), QKV_B, (bf16*)(P.ws + WS_QKV), QKV_B, lds, wave, lane); }
                          pg8::Gemm g{(const bf16*)(P.ws + WS_H), (const bf16*)(P.ws + WS_WQKVB), NR, QKV_B, DM, nullptr, 0}; pg8::LatOrder S; S.init(QKV_B, G, (int)blockIdx.x);
                          pg8::EpiRopeB E{(bf16*)(P.ws + WS_QKV), QKV_B, (const float*)(P.ws + WS_ROPE), (const float*)(P.ws + WS_ROPE) + 4096, 1152}; REP(4) { pg8::gemm_phase<pg8::EpiRopeB, pg8::LatOrder, true, true>(lds, g, S, E, HW_TID(wave0)); } SEAM(pb + 0); }
        if (IN(pb + 2)) { REP(10) { phase_attn_swa(P, lds, wave0); } SEAM(pb + 2); }
        if (IN(pb + 3)) { { LAUNDER(); ctx_gemm<false>((const bf16*)(P.ws + WS_O), (const bf16*)(P.ws + WS_WOB), DM, (bf16*)(P.ws + WS_Y), DM, lds, wave, lane); }
                          pg8::Gemm g{(const bf16*)(P.ws + WS_O), (const bf16*)(P.ws + WS_WOB), NR, DM, DM, nullptr, 0}; pg8::LatOrder S; S.init(DM, G, (int)blockIdx.x);
                          EpiPlain E{(bf16*)(P.ws + WS_Y), DM, nullptr, 0, 0, 1.f}; REP(4) { pg8::gemm_phase<EpiPlain, pg8::LatOrder, true, true>(lds, g, S, E, HW_TID(wave0)); } SEAM(pb + 3); }
    } else {
        if (IN(pb + 0)) { { LAUNDER(); REP(5) { moe_convert(P, LAYER, lds, blockIdx.x * NWAVES + wave, G * NWAVES, wave, lane); __syncthreads(); } }
                          { LAUNDER(); ctx_gemm<false>((const bf16*)(P.ws + WS_H), (const bf16*)(P.ws + WS_WQKVC), QKV_C, (bf16*)(P.ws + WS_QKV), QKV_C, lds, wave, lane); }
                          pg8::Gemm g{(const bf16*)(P.ws + WS_H), (const bf16*)(P.ws + WS_WQKVC), NR, QKV_C, DM, nullptr, 0}; pg8::LatOrder S; S.init(QKV_C, G, (int)blockIdx.x);
                          EpiPlain E{(bf16*)(P.ws + WS_QKV), QKV_C, nullptr, 0, 0, 1.f}; REP(4) { pg8::gemm_phase<EpiPlain, pg8::LatOrder, true, true>(lds, g, S, E, HW_TID(wave0)); } SEAM(pb + 0); }
        if (IN(pb + 1)) { LAUNDER(); if (PROBE_GROUP == 9) phase_normrope_gqa(P, wave, lane, (bf16*)(P.ws + WS_END)); phase_normrope_gqa(P, wave, lane); phase_vt_gqa(P, lds, wave, lane); SEAM(pb + 1); }
        if (IN(pb + 2)) { REP(1) { phase_attn_gqa(P, lds, wave0); } SEAM(pb + 2); }
        if (IN(pb + 3)) { { LAUNDER(); ctx_gemm<false>((const bf16*)(P.ws + WS_O), (const bf16*)(P.ws + WS_WOC), DM, (bf16*)(P.ws + WS_Y), DM, lds, wave, lane); }
                          pg8::Gemm g{(const bf16*)(P.ws + WS_O), (const bf16*)(P.ws + WS_WOC), NR, DM, DM, nullptr, 0}; pg8::LatOrder S; S.init(DM, G, (int)blockIdx.x);
                          EpiPlain E{(bf16*)(P.ws + WS_Y), DM, nullptr, 0, 0, 1.f}; REP(4) { pg8::gemm_phase<EpiPlain, pg8::LatOrder, true, true>(lds, g, S, E, HW_TID(wave0)); } SEAM(pb + 3); }
    }
    if (IN(pb + 4)) { LAUNDER(); if (PROBE_GROUP == 7) { __syncthreads(); phase_ln1(P, LAYER, lds, tid, wave, lane, (float*)(P.ws + WS_END)); } __syncthreads(); phase_ln1(P, LAYER, lds, tid, wave, lane); SEAM(pb + 4); }
    if (IN(pb + 5)) { LAUNDER(); REP(12) { __syncthreads(); phase_dispatch(P, lds, tid, wave, lane); } SEAM(pb + 5); }
    if (IN(pb + 6)) { const int npan = ((const int*)(P.ws + WS_PANE))[0]; const int* pe = (const int*)(P.ws + WS_PANE) + 16;
                      pg8::Gemm g{(const bf16*)(P.ws + WS_H), (const bf16*)(P.ws + WS_WUP), npan * 256, DM, DM, pe, (size_t)DM * DM * 2, (const int*)(P.ws + WS_ROWMAP)}; pg8::StaticOrder S; S.init(npan * 256, DM, G, (int)blockIdx.x);
                      const int U = npan * 4, full = (U % G <= 64) ? (U / G) * G : U; S.lim = full;
                      pg8::EpiSwiglu E{(bf16*)(P.ws + WS_ACT), DEXP, (const float*)(P.ws + WS_GSLOT)}; REP(2) { pg8::gemm_phase<pg8::EpiSwiglu, pg8::StaticOrder, true, true, true>(lds, g, S, E, HW_TID(wave0)); }
                      pg8::gemm_tail<true>(lds, g, S, full, U, (bf16*)(P.ws + WS_ACT), DEXP, (const float*)(P.ws + WS_GSLOT), HW_TID(wave0)); SEAM(pb + 6); }
    if (IN(pb + 7)) { const int npan = ((const int*)(P.ws + WS_PANE))[0]; const int* pe = (const int*)(P.ws + WS_PANE) + 16;
                      pg8::Gemm g{(const bf16*)(P.ws + WS_ACT), (const bf16*)(P.ws + WS_WDN), npan * 256, DM, DEXP, pe, (size_t)DM * DEXP * 2}; pg8::StaticOrder S; S.init(npan * 256, DM, G, (int)blockIdx.x);
                      const int U = npan * 4, full = (U % G <= 64) ? (U / G) * G : U; S.lim = full;
                      EpiPlain E{(bf16*)(P.ws + WS_HS), DM, nullptr, 0, 0, 1.f}; REP(2) { pg8::gemm_phase<EpiPlain, pg8::StaticOrder, true, true>(lds, g, S, E, HW_TID(wave0)); }
                      pg8::gemm_tail<false>(lds, g, S, full, U, (bf16*)(P.ws + WS_HS), DM, nullptr, HW_TID(wave0)); SEAM(pb + 7); }
    if (IN(pb + 8)) { LAUNDER(); if (PROBE_GROUP == 8) phase_ln2(P, LAYER, wave, lane, (float*)(P.ws + WS_END)); phase_ln2(P, LAYER, wave, lane); if (LAYER < 3) SEAM(pb + 8); }
}
__global__ void __launch_bounds__(NTHREADS, 2) fwd_kernel(Params P) {
    extern __shared__ __attribute__((aligned(16))) unsigned char lds_raw[];
    LAS unsigned char* lds = (LAS unsigned char*)lds_raw;
    unsigned* ctl = (unsigned*)(P.ws + WS_CTL);
    const int wave0 = __builtin_amdgcn_readfirstlane((int)threadIdx.x >> 6);
    for (int u = threadIdx.x; u < (LDS_BYTES - LDSCTL_OFF) / 4; u += NTHREADS) ((LAS unsigned*)(lds + LDSCTL_OFF))[u] = 0u;
    __syncthreads();
    XcdBarrier bar = xcd_barrier_post(ctl + CW_BAR, (volatile LAS unsigned*)(lds + MISC_OFF) + 8);
    const int lo = P.ph_lo, hi = P.ph_hi;
    if (IN(0)) { LAUNDER(); REP(11) { phase_prologue(P, lds, tid, wave, lane); __syncthreads(); } SEAM(0); }
    if (IN(1)) { LAUNDER(); REP(5) { phase_h0(P, wave, lane); } phase_s5_tables(P, tid); SEAM(1); }
    run_layer<0>(P, lds, bar, lo, hi, wave0);
    run_layer<1>(P, lds, bar, lo, hi, wave0);
    run_layer<2>(P, lds, bar, lo, hi, wave0);
    run_layer<3>(P, lds, bar, lo, hi, wave0);
}
#undef LAUNDER
#undef REP
#undef IN
#undef SEAM

extern "C" void kernel_launch(void* const* d_in, const int* in_sizes, int n_in, void* d_out, int out_size, void* d_ws, size_t ws_size, hipStream_t stream) {
    static int ok = 0;
    if (ok == 0) {
        if (n_in != 30 || in_sizes[0] != NBATCH * SEQ * DM || out_size != NBATCH * SEQ * DM || ws_size < WS_END + (PROBE_GROUP >= 7 ? 140 * MiB : 0)) {
            fprintf(stderr, "kernel_launch: shape mismatch: n_in %d in0 %d out %d ws %zu (need %zu)\n", n_in, n_in > 0 ? in_sizes[0] : -1, out_size, ws_size, (size_t)WS_END); ok = -1; return; }
        if (hipFuncSetAttribute((const void*)fwd_kernel, hipFuncAttributeMaxDynamicSharedMemorySize, LDS_BYTES) != hipSuccess) { fprintf(stderr, "kernel_launch: hipFuncSetAttribute failed\n"); ok = -1; return; }
        int dev = 0, cus = 0, per_cu = 0;
        (void)hipGetDevice(&dev); (void)hipDeviceGetAttribute(&cus, hipDeviceAttributeMultiprocessorCount, dev);
        if (hipOccupancyMaxActiveBlocksPerMultiprocessor(&per_cu, (const void*)fwd_kernel, NTHREADS, LDS_BYTES) != hipSuccess || per_cu < 1 || cus < NGRID)
            fprintf(stderr, "kernel_launch: note: occupancy query says %d blocks per CU on %d CUs; this kernel needs %d resident blocks\n", per_cu, cus, NGRID);
        (void)hipGetLastError();
        ok = 1;
    }
    if (ok < 0) return;
    if (hipMemsetAsync((char*)d_ws + WS_CTL, 0, CTL_ZERO_BYTES, stream) != hipSuccess) { fprintf(stderr, "kernel_launch: memset failed\n"); return; }
    Params p{};
    for (int i = 0; i < 30; ++i) p.in[i] = (const float*)d_in[i];
    p.out = (float*)d_out; p.ws = (unsigned char*)d_ws;
#if MK_MULTI
    for (int ph = 0; ph < NPHASE; ++ph) { p.ph_lo = ph; p.ph_hi = ph + 1; hipLaunchKernelGGL(fwd_kernel, dim3(NGRID), dim3(NTHREADS), LDS_BYTES, stream, p); }
#else
    p.ph_lo = 0; p.ph_hi = NPHASE;
    hipLaunchKernelGGL(fwd_kernel, dim3(NGRID), dim3(NTHREADS), LDS_BYTES, stream, p);
#endif
    const hipError_t le = hipPeekAtLastError();
    if (le != hipSuccess) fprintf(stderr, "kernel_launch: launch failed: %s\n", hipGetErrorName(le));
}
```
